# Optimizing an MI355X kernel written in HIP

```python
import functools
import jax, jax.numpy as jnp
from jax import lax
import numpy as np

D_MODEL = 1024
BATCH = 2
SEQ = 8192
DEPTH = 1
DEC_BATCH = 32
DEC_SEQ = 8
PAST_LEN = 8192
PAGE_SIZE = 128

A_HEADS = 8
A_HEAD_DIM = 64
A_WIDTH = A_HEADS * A_HEAD_DIM
Q_BLOCK = 128
B_HEADS = 4
B_KEY_DIM = 128
B_VAL_DIM = 256
B_KEY_WIDTH = B_HEADS * B_KEY_DIM
B_VAL_WIDTH = B_HEADS * B_VAL_DIM
GATE_RANK = 16
GATE_TEMP = 16.0
GLA_CHUNK = 64
D_FF = 2816
CONV_WIDTH = 3
EPS = 1e-6

IN_SPLITS = (A_WIDTH, A_WIDTH, A_WIDTH, A_HEADS, B_KEY_WIDTH, B_KEY_WIDTH, B_VAL_WIDTH, GATE_RANK, B_VAL_WIDTH, D_MODEL, D_MODEL)
D_IN = 3 * A_WIDTH + A_HEADS + 2 * B_KEY_WIDTH + 2 * B_VAL_WIDTH + GATE_RANK + 2 * D_MODEL

kernel_name = 'fox_gla_parallel_convffn_step'


def rmsnorm(x, g):
    xf = x.astype(jnp.float32)
    xf = xf * lax.rsqrt(jnp.mean(xf * xf, axis=-1, keepdims=True) + EPS)
    return xf.astype(x.dtype) * g


def project_mixer_inputs(hn, w_in, b_f, w_alpha2, b_alpha):
    b, t, _ = hn.shape
    u = hn @ w_in
    offs = np.cumsum(IN_SPLITS)[:-1].tolist()
    q_a, k_a, v_a, f_a, q_b, k_b, v_b, a_low, r_b, gate_a, gate_b = jnp.split(u, offs, axis=-1)
    logf = jax.nn.log_sigmoid((f_a + b_f).astype(jnp.float32))
    log_alpha = jax.nn.log_sigmoid((a_low @ w_alpha2 + b_alpha).astype(jnp.float32)) / GATE_TEMP
    return (q_a.reshape(b, t, A_HEADS, A_HEAD_DIM) * A_HEAD_DIM ** -0.5,
            k_a.reshape(b, t, A_HEADS, A_HEAD_DIM),
            v_a.reshape(b, t, A_HEADS, A_HEAD_DIM),
            logf,
            q_b.reshape(b, t, B_HEADS, B_KEY_DIM) * B_KEY_DIM ** -0.5,
            k_b.reshape(b, t, B_HEADS, B_KEY_DIM),
            v_b.reshape(b, t, B_HEADS, B_VAL_DIM),
            log_alpha.reshape(b, t, B_HEADS, B_KEY_DIM),
            r_b, gate_a, gate_b)


def fox_prompt(q, k, v, logf):
    b, t, h, d = q.shape
    n_blocks = t // Q_BLOCK
    c = jnp.cumsum(logf, axis=1).transpose(0, 2, 1)
    kpos = jnp.arange(t)

    def block(i):
        start = i * Q_BLOCK
        qb = lax.dynamic_slice_in_dim(q, start, Q_BLOCK, axis=1)
        cq = lax.dynamic_slice_in_dim(c, start, Q_BLOCK, axis=2)
        qpos = start + jnp.arange(Q_BLOCK)
        logits = (jnp.einsum('bqhd,bkhd->bhqk', qb, k, preferred_element_type=jnp.float32)
                  + cq[..., :, None] - c[..., None, :])
        logits = jnp.where(kpos[None, :] <= qpos[:, None], logits, -jnp.inf)
        p = jax.nn.softmax(logits, axis=-1).astype(v.dtype)
        return jnp.einsum('bhqk,bkhd->bqhd', p, v)

    out = lax.map(block, jnp.arange(n_blocks))
    return out.transpose(1, 0, 2, 3, 4).reshape(b, t, h * d)


def fox_sample(q, k, v, logf, k_past, v_past, logf_past):
    db, t, h, d = q.shape
    past_len = k_past.shape[1]
    c_new = jnp.cumsum(logf, axis=1).transpose(0, 2, 1)
    lp = logf_past.astype(jnp.float32)
    suffix = (lax.cumsum(lp, axis=1, reverse=True) - lp).transpose(0, 2, 1)
    s_past = (jnp.einsum('bqhd,bkhd->bhqk', q, k_past, preferred_element_type=jnp.float32)
              + c_new[..., :, None] + suffix[..., None, :])
    s_new = (jnp.einsum('bqhd,bkhd->bhqk', q, k, preferred_element_type=jnp.float32)
             + c_new[..., :, None] - c_new[..., None, :])
    causal = jnp.tril(jnp.ones((t, t), dtype=bool))
    s_new = jnp.where(causal, s_new, -jnp.inf)
    p = jax.nn.softmax(jnp.concatenate([s_past, s_new], axis=-1), axis=-1).astype(v.dtype)
    out = (jnp.einsum('bhqk,bkhd->bqhd', p[..., :past_len], v_past)
           + jnp.einsum('bhqk,bkhd->bqhd', p[..., past_len:], v))
    return out.reshape(db, t, h * d)


def gla_chunk(state, xs):
    q, k, v, log_alpha = xs
    qf, kf, vf = q.astype(jnp.float32), k.astype(jnp.float32), v.astype(jnp.float32)
    c = q.shape[2]
    bcum = jnp.cumsum(log_alpha.astype(jnp.float32), axis=2)
    o_inter = jnp.einsum('bhtk,bhkv->bhtv', qf * jnp.exp(bcum), state)
    causal = jnp.tril(jnp.ones((c, c), dtype=bool))
    diff = bcum[:, :, :, None, :] - bcum[:, :, None, :, :]
    decay = jnp.exp(jnp.where(causal[:, :, None], diff, -jnp.inf))
    attn = jnp.einsum('bhtk,bhsk,bhtsk->bhts', qf, kf, decay)
    o = o_inter + jnp.einsum('bhts,bhsv->bhtv', attn, vf)
    b_last = bcum[:, :, -1:, :]
    new_state = (jnp.exp(b_last[:, :, 0, :])[..., None] * state
                 + jnp.einsum('bhsk,bhsv->bhkv', kf * jnp.exp(b_last - bcum), vf))
    return new_state, o


def gla_prompt(q, k, v, log_alpha):
    b, t, h, dk = q.shape
    dv = v.shape[-1]
    n_chunks = t // GLA_CHUNK

    def chunks(a):
        return a.reshape(b, n_chunks, GLA_CHUNK, h, a.shape[-1]).transpose(1, 0, 3, 2, 4)

    s0 = jnp.zeros((b, h, dk, dv), jnp.float32)
    s_fin, o = lax.scan(gla_chunk, s0, (chunks(q), chunks(k), chunks(v), chunks(log_alpha)))
    return o.transpose(1, 0, 3, 2, 4).reshape(b, t, h, dv).astype(v.dtype), s_fin


def gla_sample(state, q, k, v, log_alpha):
    tr = lambda a: a.transpose(0, 2, 1, 3)
    s_new, o = gla_chunk(state.astype(jnp.float32), (tr(q), tr(k), tr(v), tr(log_alpha)))
    return tr(o).astype(v.dtype), s_new


def conv_ffn(hn, conv_buf, w_up, w_conv, b_conv, w_down):
    t = hn.shape[1]
    u = hn @ w_up
    full = jnp.concatenate([conv_buf.astype(u.dtype), u], axis=1)
    conv = b_conv + sum(full[:, i:i + t] * w_conv[i] for i in range(CONV_WIDTH))
    a, g = jnp.split(conv, 2, axis=-1)
    return (jax.nn.gelu(g, approximate=True) * a) @ w_down, full[:, t:]


def layer_forward(x, attn_fn, gla_fn, conv_buf, g_pre_mix, w_in, b_f, w_alpha2, b_alpha, g_gla,
                  w_proj_a, w_proj_b, w_out, g_post_mix, g_pre_ffn, w_up, w_conv, b_conv, w_down, g_post_ffn):
    b, t, _ = x.shape
    hn = rmsnorm(x, g_pre_mix)
    q_a, k_a, v_a, logf, q_b, k_b, v_b, log_alpha, r_b, gate_a, gate_b = project_mixer_inputs(
        hn, w_in, b_f, w_alpha2, b_alpha)
    o_a = attn_fn(q_a, k_a, v_a, logf)
    o_b, gla_state = gla_fn(q_b, k_b, v_b, log_alpha)
    o_b = rmsnorm(o_b, g_gla).reshape(b, t, B_VAL_WIDTH) * jax.nn.silu(r_b)
    merged = jax.nn.sigmoid(gate_a) * (o_a @ w_proj_a) + jax.nn.sigmoid(gate_b) * (o_b @ w_proj_b)
    x = x + rmsnorm(merged @ w_out, g_post_mix)
    f, new_conv = conv_ffn(rmsnorm(x, g_pre_ffn), conv_buf, w_up, w_conv, b_conv, w_down)
    y = x + rmsnorm(f, g_post_ffn)
    return y, k_a, v_a, logf, gla_state, new_conv


def setup_inputs(seed: int = 0) -> dict:
    key = jax.random.key(seed)
    ks = jax.random.split(key, 24)
    n_pages = PAST_LEN // PAGE_SIZE
    n_pool = (DEC_BATCH * n_pages * 5) // 4

    def nrm(k, shape, scale=1.0):
        return scale * jax.random.normal(k, shape, jnp.float32)

    page_table = jax.random.permutation(ks[7], n_pool)[: DEC_BATCH * n_pages].reshape(DEC_BATCH, n_pages).astype(jnp.int32)
    return {
        'x_prompt': nrm(ks[0], (BATCH, SEQ, D_MODEL)),
        'x_sample': nrm(ks[1], (DEC_BATCH, DEC_SEQ, D_MODEL)),
        'cache_k': nrm(ks[2], (DEPTH, n_pool, PAGE_SIZE, A_HEADS, A_HEAD_DIM)),
        'cache_v': nrm(ks[3], (DEPTH, n_pool, PAGE_SIZE, A_HEADS, A_HEAD_DIM)),
        'cache_logf': jax.nn.log_sigmoid(8.0 + nrm(ks[4], (DEPTH, n_pool, PAGE_SIZE, A_HEADS), 0.5)),
        'state_gla': nrm(ks[5], (DEPTH, DEC_BATCH, B_HEADS, B_KEY_DIM, B_VAL_DIM)),
        'state_conv': nrm(ks[6], (DEPTH, DEC_BATCH, CONV_WIDTH - 1, 2 * D_FF)),
        'page_table': page_table,
        'g_pre_mix': 1.0 + nrm(ks[8], (DEPTH, D_MODEL), 0.01),
        'w_in': nrm(ks[9], (DEPTH, D_MODEL, D_IN), D_MODEL ** -0.5),
        'b_f': jnp.linspace(3.0, 8.0, A_HEADS, dtype=jnp.float32) + nrm(ks[10], (DEPTH, A_HEADS), 0.1),
        'w_alpha2': nrm(ks[11], (DEPTH, GATE_RANK, B_KEY_WIDTH), GATE_RANK ** -0.5),
        'b_alpha': nrm(ks[12], (DEPTH, B_KEY_WIDTH), 0.1),
        'g_gla': 1.0 + nrm(ks[13], (DEPTH, B_VAL_DIM), 0.01),
        'w_proj_a': nrm(ks[14], (DEPTH, A_WIDTH, D_MODEL), A_WIDTH ** -0.5),
        'w_proj_b': nrm(ks[15], (DEPTH, B_VAL_WIDTH, D_MODEL), B_VAL_WIDTH ** -0.5),
        'w_out': nrm(ks[16], (DEPTH, D_MODEL, D_MODEL), D_MODEL ** -0.5),
        'g_post_mix': 1.0 + nrm(ks[17], (DEPTH, D_MODEL), 0.01),
        'g_pre_ffn': 1.0 + nrm(ks[18], (DEPTH, D_MODEL), 0.01),
        'w_up': nrm(ks[19], (DEPTH, D_MODEL, 2 * D_FF), D_MODEL ** -0.5),
        'w_conv': nrm(ks[20], (DEPTH, CONV_WIDTH, 2 * D_FF), CONV_WIDTH ** -0.5),
        'b_conv': nrm(ks[21], (DEPTH, 2 * D_FF), 0.01),
        'w_down': nrm(ks[22], (DEPTH, D_FF, D_MODEL), D_FF ** -0.5),
        'g_post_ffn': 1.0 + nrm(ks[23], (DEPTH, D_MODEL), 0.01),
    }


def reference(x_prompt, x_sample, cache_k, cache_v, cache_logf, state_gla, state_conv, page_table,
              g_pre_mix, w_in, b_f, w_alpha2, b_alpha, g_gla, w_proj_a, w_proj_b, w_out, g_post_mix,
              g_pre_ffn, w_up, w_conv, b_conv, w_down, g_post_ffn):
    dec_batch, n_pages = page_table.shape
    past_len = n_pages * PAGE_SIZE
    conv0 = jnp.zeros((x_prompt.shape[0], CONV_WIDTH - 1, 2 * D_FF), x_prompt.dtype)
    yp, ys = x_prompt, x_sample
    kp, vp, fp, gp, cp = [], [], [], [], []
    ksm, vsm, fsm, gsm, csm = [], [], [], [], []
    for l in range(DEPTH):
        w = (g_pre_mix[l], w_in[l], b_f[l], w_alpha2[l], b_alpha[l], g_gla[l], w_proj_a[l], w_proj_b[l],
             w_out[l], g_post_mix[l], g_pre_ffn[l], w_up[l], w_conv[l], b_conv[l], w_down[l], g_post_ffn[l])
        yp, k_a, v_a, logf, st, cb = layer_forward(yp, fox_prompt, gla_prompt, conv0, *w)
        kp.append(k_a); vp.append(v_a); fp.append(logf); gp.append(st); cp.append(cb)
        k_past = cache_k[l][page_table].reshape(dec_batch, past_len, A_HEADS, A_HEAD_DIM)
        v_past = cache_v[l][page_table].reshape(dec_batch, past_len, A_HEADS, A_HEAD_DIM)
        f_past = cache_logf[l][page_table].reshape(dec_batch, past_len, A_HEADS)
        attn_s = functools.partial(fox_sample, k_past=k_past, v_past=v_past, logf_past=f_past)
        gla_s = functools.partial(gla_sample, state_gla[l])
        ys, k_a, v_a, logf, st, cb = layer_forward(ys, attn_s, gla_s, state_conv[l], *w)
        ksm.append(k_a); vsm.append(v_a); fsm.append(logf); gsm.append(st); csm.append(cb)
    new_k_prompt = jnp.stack(kp)
    new_v_prompt = jnp.stack(vp)
    new_logf_prompt = jnp.stack(fp)
    new_gla_prompt = jnp.stack(gp)
    new_conv_prompt = jnp.stack(cp)
    new_k_sample = jnp.stack(ksm)
    new_v_sample = jnp.stack(vsm)
    new_logf_sample = jnp.stack(fsm)
    new_gla_sample = jnp.stack(gsm)
    new_conv_sample = jnp.stack(csm)
    return (yp, ys, new_k_prompt, new_v_prompt, new_logf_prompt, new_gla_prompt, new_conv_prompt,
            new_k_sample, new_v_sample, new_logf_sample, new_gla_sample, new_conv_sample)
```

```cpp
#include <hip/hip_runtime.h>
#include <cstdio>
#include <cstdint>
namespace pg8 {
#define PG8_LAS __attribute__((address_space(3)))
typedef unsigned short bf16_t;
typedef short bf16x8 __attribute__((ext_vector_type(8)));
typedef float f32x4 __attribute__((ext_vector_type(4)));
typedef unsigned u32x4 __attribute__((ext_vector_type(4)));
constexpr int BM = 256, BK = 64, HALF = 128, HTB = HALF * BK * 2  , STAGE_BYTES = 8 * HTB, NXCD = 8, WGM = 8;

__host__ __device__ __forceinline__ int lds_byte(int r, int c) { const int st = (r >> 4) * 2 + (c >> 5), rr = r & 15, cc = c & 31, ob = rr * 64 + cc * 2; return st * 1024 + (ob ^ (((ob >> 9) & 1) << 5)); }
__host__ __device__ __forceinline__ void stage_rc(int b, int& R, int& C) { const int st = b / 1024, sb = b % 1024, swz = sb ^ (((sb >> 9) & 1) << 5); R = (st >> 1) * 16 + swz / 64; C = (st & 1) * 32 + (swz % 64) / 2; }
__host__ __device__ __forceinline__ int perm32(int rho) { const int n = rho >> 4, i = rho & 15; return 8 * (i >> 2) + 4 * n + (i & 3); }

struct Unit { int pm, pn; };
struct Gemm { const bf16_t* A; const bf16_t* Bt; int M, N, K; };

struct StaticOrder {
    int nM, nN, nwg, G, c;
    __host__ __device__ void init(int M, int N, int G_, int c_) { nM = M / BM; nN = N / BM; nwg = nM * nN; G = G_; c = c_; }
    __host__ __device__ bool next(int i, Unit& u) const {
        const long L = (long)i * G + c; if (L >= nwg) return false;
        int wgid = (int)L; { const int q = nwg / NXCD, r = nwg % NXCD, xcd = wgid % NXCD, off = wgid / NXCD; wgid = (xcd < r ? xcd * (q + 1) : r * (q + 1) + (xcd - r) * q) + off; }
        const int nig = WGM * nN, gid = wgid / nig, fm = gid * WGM, gsz = (nM - fm) < WGM ? (nM - fm) : WGM;
        u.pm = fm + ((wgid % nig) % gsz); u.pn = (wgid % nig) / gsz; return true;
    }
    __device__ __forceinline__ void a_ready(const Unit&) const {}
    __device__ __forceinline__ void done(const Unit&) const {}
};

__device__ __forceinline__ unsigned cvt_pk_bf16(float lo, float hi) { unsigned r; asm volatile("v_cvt_pk_bf16_f32 %0, %1, %2" : "=v"(r) : "v"(lo), "v"(hi)); return r; }
typedef float f32x2 __attribute__((ext_vector_type(2)));

template <class F> struct EpiGen {
    static constexpr bool PERM = true, AFTER_DRAIN = false;
    F f;
    __device__ __forceinline__ void operator()(const f32x4 (&acc)[2][2][4][2], const Unit& u, int wr, int wc, int fr, int fq) const {
        const int row0 = u.pm * BM + wr * 64 + fr, col0 = u.pn * BM + wc * 32 + 8 * fq;
#pragma unroll
        for (int ai = 0; ai < 2; ++ai)
#pragma unroll
            for (int m = 0; m < 4; ++m)
#pragma unroll
                for (int bj = 0; bj < 2; ++bj)
                    f.store8(row0 + ai * HALF + m * 16, col0 + bj * HALF, u.pn, acc[ai][bj][m][0], acc[ai][bj][m][1]);
    }
};
template <class Epi, class Sched, bool ALIGN_EPI = false, bool SP2 = false>
__device__ __forceinline__ void gemm_phase(PG8_LAS unsigned char* lds, const Gemm g, const Sched& S, const Epi& E) {
    const int tid = threadIdx.x, wid = __builtin_amdgcn_readfirstlane(tid >> 6), lane = tid & 63, wr = wid >> 2, wc = wid & 3, fr = lane & 15, fq = lane >> 4;
    const int K = g.K, nt = K / BK;
    unsigned voffA[2], voffB[2];
#pragma unroll
    for (int i = 0; i < 2; ++i) { int R, C; stage_rc(tid * 16 + i * 8192, R, C); const int Rb = Epi::PERM ? ((R & ~31) + perm32(R & 31)) : R;
        voffA[i] = (unsigned)(R * K + C) * 2u; voffB[i] = (unsigned)(Rb * K + C) * 2u; }
    const size_t kstep = (size_t)(BK * 2);
    const size_t hstep = (size_t)HALF * K * 2;
    const size_t tstep = 2 * hstep;
    const unsigned ldsw = (unsigned)wid * 1024u;
    const int aoff = lds_byte(wr * 64 + fr, fq * 8), boff = lds_byte(wc * 32 + fr, fq * 8);
#define PG8_SA(b, h) (((b) * 2 + (h)) * HTB)
#define PG8_SB(b, h) ((4 + (b) * 2 + (h)) * HTB)
#define PG8_STAGE(bufoff, gbase, voff) do { _Pragma("unroll") for (int _i = 0; _i < 2; ++_i) \
        __builtin_amdgcn_global_load_lds((const unsigned*)((const char*)(gbase) + (voff)[_i]), (PG8_LAS unsigned*)(lds + (bufoff) + ldsw + _i * 8192), 16, 0, 0); } while (0)
#define PG8_LDA(dst, b, h) do { _Pragma("unroll") for (int m = 0; m < 4; ++m) _Pragma("unroll") for (int k = 0; k < 2; ++k) dst[m][k] = *(const PG8_LAS bf16x8*)(lds + PG8_SA(b, h) + aoff + m * 2048 + k * 1024); } while (0)
#define PG8_LDB(dst, b, h) do { _Pragma("unroll") for (int n = 0; n < 2; ++n) _Pragma("unroll") for (int k = 0; k < 2; ++k) dst[n][k] = *(const PG8_LAS bf16x8*)(lds + PG8_SB(b, h) + boff + n * 2048 + k * 1024); } while (0)
#define PG8_MMA(ai, bj, At, Bt) do { __builtin_amdgcn_s_setprio(1); _Pragma("unroll") for (int m = 0; m < 4; ++m) _Pragma("unroll") for (int n = 0; n < 2; ++n) _Pragma("unroll") for (int k = 0; k < 2; ++k) \
        acc[ai][bj][m][n] = __builtin_amdgcn_mfma_f32_16x16x32_bf16(Bt[n][k], At[m][k], acc[ai][bj][m][n], 0, 0, 0); __builtin_amdgcn_s_setprio(0); } while (0)
#define PG8_WAIT_V(n) asm volatile("s_waitcnt vmcnt(" #n ")" ::: "memory")
#define PG8_WAIT_L(n) asm volatile("s_waitcnt lgkmcnt(" #n ")" ::: "memory")
#define PG8_BAR __builtin_amdgcn_s_barrier()
#define PG8_SCHED __builtin_amdgcn_sched_barrier(0)
    Unit cur, nxt; int ui = 0;
    if (!S.next(0, cur)) return;
    f32x4 acc[2][2][4][2];
#pragma unroll
    for (int a = 0; a < 2; ++a)
#pragma unroll
        for (int b = 0; b < 2; ++b)
#pragma unroll
            for (int m = 0; m < 4; ++m)
#pragma unroll
                for (int n = 0; n < 2; ++n) acc[a][b][m][n] = (f32x4){0.f, 0.f, 0.f, 0.f};
    bf16x8 At[4][2], B0[2][2], B1[2][2];
    const char* cA = (const char*)g.A + (size_t)cur.pm * tstep; const char* cB = (const char*)g.Bt + (size_t)cur.pn * tstep;
    S.a_ready(cur);
    if constexpr (SP2) {
        PG8_STAGE(PG8_SB(0, 0), cB, voffB); PG8_STAGE(PG8_SB(0, 1), cB + hstep, voffB); PG8_STAGE(PG8_SA(0, 0), cA, voffA); PG8_STAGE(PG8_SA(0, 1), cA + hstep, voffA);
        if (wr == 1) PG8_BAR;
        PG8_WAIT_V(2); PG8_BAR;
        PG8_STAGE(PG8_SB(1, 0), cB + kstep, voffB); PG8_STAGE(PG8_SA(1, 0), cA + kstep, voffA); PG8_STAGE(PG8_SB(1, 1), cB + hstep + kstep, voffB);
        PG8_WAIT_V(6); PG8_BAR;
    } else {
        PG8_STAGE(PG8_SB(0, 0), cB, voffB); PG8_STAGE(PG8_SA(0, 0), cA, voffA); PG8_STAGE(PG8_SB(0, 1), cB + hstep, voffB); PG8_STAGE(PG8_SA(0, 1), cA + hstep, voffA);
        if (wr == 1) PG8_BAR;
        PG8_WAIT_V(4); PG8_BAR;
        PG8_STAGE(PG8_SB(1, 0), cB + kstep, voffB); PG8_STAGE(PG8_SA(1, 0), cA + kstep, voffA); PG8_STAGE(PG8_SB(1, 1), cB + hstep + kstep, voffB);
        PG8_WAIT_V(6); PG8_BAR;
    }
    for (;;) {
        const bool has_next = S.next(ui + 1, nxt);
        const char* nA = has_next ? (const char*)g.A + (size_t)nxt.pm * tstep : cA; const char* nB = has_next ? (const char*)g.Bt + (size_t)nxt.pn * tstep : cB;
        for (int t = 0; t < nt; t += 2) {
            const bool last = (t == nt - 2);
            const char* a1 = cA + (size_t)(t + 1) * kstep;
            const char* a2 = last ? nA : cA + (size_t)(t + 2) * kstep; const char* b2 = last ? nB : cB + (size_t)(t + 2) * kstep;
            const char* a3 = a2 + kstep; const char* b3 = b2 + kstep;
            if (last && has_next) S.a_ready(nxt);
            if constexpr (SP2) {
            PG8_LDB(B0, 0, 0); PG8_LDB(B1, 0, 1); PG8_SCHED; PG8_LDA(At, 0, 0); PG8_STAGE(PG8_SA(1, 1), a1 + hstep, voffA);
            PG8_WAIT_V(8); PG8_WAIT_L(0); PG8_BAR; PG8_MMA(0, 0, At, B0); PG8_MMA(0, 1, At, B1); PG8_BAR; PG8_SCHED;
            PG8_LDA(At, 0, 1); PG8_STAGE(PG8_SB(0, 0), b2, voffB); PG8_STAGE(PG8_SB(0, 1), b2 + hstep, voffB); PG8_STAGE(PG8_SA(0, 0), a2, voffA);
            PG8_WAIT_V(8); PG8_WAIT_L(0); PG8_BAR; PG8_MMA(1, 0, At, B0); PG8_MMA(1, 1, At, B1); PG8_BAR; PG8_SCHED;
            PG8_LDB(B0, 1, 0); PG8_LDB(B1, 1, 1); PG8_SCHED; PG8_LDA(At, 1, 0); PG8_STAGE(PG8_SA(0, 1), a2 + hstep, voffA);
            PG8_WAIT_V(8); PG8_WAIT_L(0); PG8_BAR; PG8_MMA(0, 0, At, B0); PG8_MMA(0, 1, At, B1); PG8_BAR; PG8_SCHED;
            PG8_LDA(At, 1, 1); PG8_STAGE(PG8_SB(1, 0), b3, voffB); PG8_STAGE(PG8_SB(1, 1), b3 + hstep, voffB); PG8_STAGE(PG8_SA(1, 0), a3, voffA);
            PG8_WAIT_V(8); PG8_WAIT_L(0); PG8_BAR; PG8_MMA(1, 0, At, B0); PG8_MMA(1, 1, At, B1); PG8_BAR; PG8_SCHED;
            } else {
            PG8_LDB(B0, 0, 0); PG8_SCHED; PG8_LDA(At, 0, 0); PG8_STAGE(PG8_SA(1, 1), a1 + hstep, voffA);
            PG8_WAIT_L(8); PG8_BAR; PG8_WAIT_L(0); PG8_MMA(0, 0, At, B0); PG8_BAR; PG8_SCHED;
            PG8_LDB(B1, 0, 1); PG8_STAGE(PG8_SB(0, 0), b2, voffB);
            PG8_BAR; PG8_WAIT_L(0); PG8_MMA(0, 1, At, B1); PG8_BAR;
            PG8_LDA(At, 0, 1); PG8_STAGE(PG8_SA(0, 0), a2, voffA);
            PG8_BAR; PG8_WAIT_L(0); PG8_MMA(1, 0, At, B0); PG8_BAR; PG8_SCHED;
            PG8_STAGE(PG8_SB(0, 1), b2 + hstep, voffB);
            PG8_WAIT_V(6); PG8_BAR; PG8_MMA(1, 1, At, B1); PG8_BAR;
            PG8_LDB(B0, 1, 0); PG8_SCHED; PG8_LDA(At, 1, 0); PG8_STAGE(PG8_SA(0, 1), a2 + hstep, voffA);
            PG8_WAIT_L(8); PG8_BAR; PG8_WAIT_L(0); PG8_MMA(0, 0, At, B0); PG8_BAR; PG8_SCHED;
            PG8_LDB(B1, 1, 1); PG8_STAGE(PG8_SB(1, 0), b3, voffB);
            PG8_BAR; PG8_WAIT_L(0); PG8_MMA(0, 1, At, B1); PG8_BAR;
            PG8_LDA(At, 1, 1); PG8_STAGE(PG8_SA(1, 0), a3, voffA);
            PG8_BAR; PG8_WAIT_L(0); PG8_MMA(1, 0, At, B0); PG8_BAR; PG8_SCHED;
            PG8_STAGE(PG8_SB(1, 1), b3 + hstep, voffB);
            PG8_WAIT_V(6); PG8_BAR; PG8_MMA(1, 1, At, B1); PG8_BAR;
            }
        }
        if constexpr (ALIGN_EPI) { if (wr == 0) PG8_BAR; }
        if constexpr (!Epi::AFTER_DRAIN) { E(acc, cur, wr, wc, fr, fq); S.done(cur); }
        if (!has_next) break;
#pragma unroll
        for (int a = 0; a < 2; ++a)
#pragma unroll
            for (int b = 0; b < 2; ++b)
#pragma unroll
                for (int m = 0; m < 4; ++m)
#pragma unroll
                    for (int n = 0; n < 2; ++n) acc[a][b][m][n] = (f32x4){0.f, 0.f, 0.f, 0.f};
        cur = nxt; cA = nA; cB = nB; ++ui;
        if constexpr (ALIGN_EPI) { if (wr == 1) PG8_BAR; }
    }
    PG8_WAIT_V(0);
    if constexpr (!ALIGN_EPI) { if (wr == 0) PG8_BAR; }
    PG8_BAR;
    if constexpr (Epi::AFTER_DRAIN) { E.fused(acc, cur, wr, wc, fr, fq, lds, wid, lane); S.done(cur); }
#undef PG8_SA
#undef PG8_SB
#undef PG8_STAGE
#undef PG8_LDA
#undef PG8_LDB
#undef PG8_MMA
#undef PG8_WAIT_V
#undef PG8_WAIT_L
#undef PG8_BAR
#undef PG8_SCHED
}
}
#define GAS __attribute__((address_space(1)))
#define LAS __attribute__((address_space(3)))
typedef unsigned short bf16;
typedef unsigned v4u __attribute__((ext_vector_type(4)));
typedef float f32x4 __attribute__((ext_vector_type(4)));
typedef short bf16x8 __attribute__((ext_vector_type(8)));
typedef GAS unsigned gu32;
typedef GAS unsigned long long gu64;
#define RLX_AGENT __ATOMIC_RELAXED, __HIP_MEMORY_SCOPE_AGENT
#define LDS_WAIT() asm volatile("s_waitcnt lgkmcnt(0)" ::: "memory")
#define VM_WAIT() asm volatile("s_waitcnt vmcnt(0)" ::: "memory")
__device__ __forceinline__ unsigned long long rt() { return __builtin_amdgcn_s_memrealtime(); }
__device__ __forceinline__ unsigned f2bf(float f) { unsigned u = __builtin_bit_cast(unsigned, f); return (u + 0x7fffu + ((u >> 16) & 1u)) >> 16; }
__device__ __forceinline__ unsigned pk2(float lo, float hi) { return f2bf(lo) | (f2bf(hi) << 16); }

#define XB_TMO      128
#define XB_XCNT(j)  (256  + 64 * (j))
#define XB_XSUB(j)  (1280 + 64 * (j))
#define XB_XGEN(j)  (2304 + 64 * (j))
#define XB_TOP      3328
#define XB_TOPGEN   3392
#define XCD_BAR_WORDS 3456
#define XB_SPIN_CAP (1u << 18)

__device__ __forceinline__ unsigned xb_ld(unsigned* p)              { return __hip_atomic_load(p, __ATOMIC_RELAXED, __HIP_MEMORY_SCOPE_AGENT); }
__device__ __forceinline__ unsigned xb_add(unsigned* p, unsigned v) { return __hip_atomic_fetch_add(p, v, __ATOMIC_RELAXED, __HIP_MEMORY_SCOPE_AGENT); }
__device__ __forceinline__ unsigned xb_xcc_id() { return (unsigned)__builtin_amdgcn_s_getreg((3 << 11) | 20) & 0xFu; }
#define XB_SPIN(cond, bar) do { unsigned _sp = 0; while (cond) { __builtin_amdgcn_s_sleep(1); \
    if ((++_sp & 255u) == 0u) { if (xb_ld(&(bar)[XB_TMO])) break; if (_sp > XB_SPIN_CAP) { atomicAdd(&(bar)[XB_TMO], 1u); break; } } } } while (0)

struct XcdBarrier {
    unsigned* bar; unsigned x;
    volatile LAS unsigned* st;
};

__device__ __forceinline__ XcdBarrier xcd_barrier_post(unsigned* bar, volatile LAS unsigned* st) {
    XcdBarrier b; b.bar = bar; b.x = xb_xcc_id(); b.st = st;
    if (threadIdx.x == 0) (void)xb_add(&bar[XB_XCNT(b.x)], 1u);
    return b;
}
__device__ __forceinline__ void xcd_barrier_complete(unsigned* bar, unsigned x, unsigned& nloc, unsigned& nx) {
    const unsigned G = gridDim.x * gridDim.y * gridDim.z;
    unsigned sum, cnt, mine, sp = 0u;
    for (;;) {
        sum = 0u; cnt = 0u; mine = 0u;
#pragma unroll
        for (unsigned j = 0; j < 16; ++j) { const unsigned c = xb_ld(&bar[XB_XCNT(j)]); sum += c; cnt += (c > 0u) ? 1u : 0u; mine = (j == x) ? c : mine; }
        if (sum == G) break;
        __builtin_amdgcn_s_sleep(1);
        if ((++sp & 255u) == 0u) { if (xb_ld(&bar[XB_TMO])) break; if (sp > XB_SPIN_CAP) { atomicAdd(&bar[XB_TMO], 1u); break; } }
    }
    nloc = mine > 0u ? mine : 1u; nx = cnt > 0u ? cnt : 1u;
}

__device__ __forceinline__ void xcd_barrier(const XcdBarrier& b) {
    asm volatile("s_waitcnt vmcnt(0)" ::: "memory");
    __syncthreads();
    if (threadIdx.x == 0) {
        unsigned* bar = b.bar;
        __builtin_amdgcn_s_waitcnt(0);
        unsigned nloc = b.st[0], nx = b.st[1];
        if (nloc == 0u) { xcd_barrier_complete(bar, b.x, nloc, nx); b.st[0] = nloc; b.st[1] = nx; }
        const unsigned old = xb_add(&bar[XB_XSUB(b.x)], 1u);
        const unsigned gen = old / nloc;
        if (old + 1u == (gen + 1u) * nloc) {
            __builtin_amdgcn_fence(__ATOMIC_RELEASE, "agent");
            asm volatile("s_waitcnt vmcnt(0)" ::: "memory");
            const unsigned og = xb_add(&bar[XB_TOP], 1u);
            const unsigned tg = og / nx;
            if (og + 1u == (tg + 1u) * nx) xb_add(&bar[XB_TOPGEN], 1u);
            else XB_SPIN(xb_ld(&bar[XB_TOPGEN]) == tg, bar);
            __builtin_amdgcn_fence(__ATOMIC_ACQUIRE, "agent");
            xb_add(&bar[XB_XGEN(b.x)], 1u);
            asm volatile("s_waitcnt vmcnt(0)" ::: "memory");
        } else {
            XB_SPIN(xb_ld(&bar[XB_XGEN(b.x)]) == gen, bar);
            __builtin_amdgcn_fence(__ATOMIC_ACQUIRE, "agent");
            asm volatile("s_waitcnt vmcnt(0)" ::: "memory");
        }
    }
    __syncthreads();
}

constexpr int NWAVES = 8, NTHR = 512;
constexpr int DM = 1024, SEQ = 8192, NB = 2, MP = NB * SEQ;
constexpr int DB = 32, DS = 8, MS = DB * DS, MT = MP + MS;
constexpr int AH = 8, AD = 64, AW = 512;
constexpr int BH = 4, BK_ = 128, BV = 256, BKW = 512, BVW = 1024, GR = 16;
constexpr int DFF = 2816, DFF2 = 5632;
constexpr int PAST = 8192, PAGE = 128, NPAGES = 64;
constexpr int DIN = 6680, NU = 6912;
constexpr int UC_QA = 0, UC_KA = 512, UC_VA = 1024, UC_QB = 1536, UC_KB = 2048, UC_VB = 2560, UC_RB = 3584, UC_GA = 4608, UC_GB = 5632, UC_FA = 6656, UC_AL = 6664;
constexpr float EPS = 1e-6f;
constexpr float LOG2E = 1.4426950408889634f;
constexpr float C2 = 0.125f * LOG2E;
constexpr float QB_SCALE = 0.08838834764831845f;
constexpr size_t OFF_YP = 0, OFF_YS = (size_t)MP * DM, OFF_KP = OFF_YS + (size_t)MS * DM, OFF_VP = OFF_KP + (size_t)MP * AW, OFF_FP = OFF_VP + (size_t)MP * AW,
                 OFF_GP = OFF_FP + (size_t)MP * AH, OFF_CP = OFF_GP + (size_t)NB * BH * BK_ * BV, OFF_KS = OFF_CP + (size_t)NB * 2 * DFF2, OFF_VS = OFF_KS + (size_t)MS * AW,
                 OFF_FS = OFF_VS + (size_t)MS * AW, OFF_GS = OFF_FS + (size_t)MS * AH, OFF_CS = OFF_GS + (size_t)DB * BH * BK_ * BV, OUT_TOTAL = OFF_CS + (size_t)DB * 2 * DFF2;
static_assert(OUT_TOTAL == 39051264, "output size");

constexpr size_t MiB = 1u << 20;
constexpr size_t WS_CTL = 0, CTL_ZERO_BYTES = 1 * MiB;
constexpr size_t al_(size_t x) { return (x + (MiB - 1)) & ~(MiB - 1); }
constexpr size_t WS_WIN = al_(WS_CTL + CTL_ZERO_BYTES);
constexpr size_t WS_WPA = al_(WS_WIN + (size_t)NU * DM * 2);
constexpr size_t WS_WPB = al_(WS_WPA + (size_t)DM * AW * 2);
constexpr size_t WS_WOUT = al_(WS_WPB + (size_t)DM * BVW * 2);
constexpr size_t WS_WUP = al_(WS_WOUT + (size_t)DM * DM * 2);
constexpr size_t WS_WDN = al_(WS_WUP + (size_t)DFF2 * DM * 2);
constexpr size_t WS_ALOW = al_(WS_WDN + (size_t)DM * DFF * 2);
constexpr size_t WS_FA = al_(WS_ALOW + (size_t)MT * GR * 4);
constexpr size_t WS_CB = al_(WS_FA + (size_t)MT * AH * 4);
constexpr size_t WS_SB = al_(WS_CB + (size_t)NB * AH * SEQ * 4);
constexpr size_t WS_PART = al_(WS_SB + (size_t)DB * AH * PAST * 4);
constexpr size_t WS_XN = al_(WS_PART + (size_t)256 * AH * DS * 68 * 4);
constexpr size_t WS_OA = al_(WS_XN + (size_t)MT * DM * 2);
constexpr size_t WS_OB = al_(WS_OA + (size_t)MT * AW * 2);
constexpr size_t WS_MG = al_(WS_OB + (size_t)MT * BVW * 2);
constexpr size_t WS_XN2 = al_(WS_MG + (size_t)MT * DM * 2);
constexpr size_t WS_ACT = al_(WS_XN2 + (size_t)MT * DM * 2);
constexpr size_t WS_U = al_(WS_ACT + (size_t)MT * DFF * 2);
constexpr size_t WS_UU = al_(WS_U + (size_t)MT * NU * 2);
constexpr size_t WS_OBR = al_(WS_UU + (size_t)MT * DFF2 * 2);
constexpr size_t WS_TA = al_(WS_OBR + (size_t)MT * BVW * 4);
constexpr size_t WS_F1 = al_(WS_TA + (size_t)MT * DM * 4);
constexpr size_t WS_X1 = al_(WS_F1 + (size_t)MT * DM * 4);
constexpr size_t WS_F2 = al_(WS_X1 + (size_t)MT * DM * 4);
constexpr size_t WS_END = al_(WS_F2 + (size_t)MT * DM * 4);
static_assert(WS_END < (size_t)2600 * MiB, "workspace");
constexpr int CW_BAR = 4096;
constexpr int PART_STRIDE = 68;

constexpr int RING_OFF = 0, RING_BYTES = 131072;
constexpr int LDSCTL_OFF = RING_BYTES, MISC_OFF = LDSCTL_OFF + 320;
constexpr int LDS_BYTES = 147456;

typedef unsigned short bf16;
typedef unsigned v4u __attribute__((ext_vector_type(4)));
typedef unsigned v2u __attribute__((ext_vector_type(2)));
typedef float f32x4 __attribute__((ext_vector_type(4)));
typedef float f32x16 __attribute__((ext_vector_type(16)));
typedef short bf16x8 __attribute__((ext_vector_type(8)));
typedef short s16x4 __attribute__((ext_vector_type(4)));

__device__ __forceinline__ float bf2f(unsigned short u) { return __uint_as_float((unsigned)u << 16); }
__device__ __forceinline__ float bflo(unsigned u) { return __uint_as_float(u << 16); }
__device__ __forceinline__ float bfhi(unsigned u) { return __uint_as_float(u & 0xffff0000u); }
__device__ __forceinline__ float sigmoidf_(float x) { return 1.f / (1.f + __expf(-x)); }
__device__ __forceinline__ float logsigmoidf_(float x) { return fminf(x, 0.f) - log1pf(expf(-fabsf(x))); }
__device__ __forceinline__ float wave_sum(float v) {
#pragma unroll
    for (int o = 1; o < 64; o <<= 1) v += __shfl_xor(v, o);
    return v;
}

struct Ctx {
    LAS unsigned char* lds;
    int tid, lane, wave, G, bid;
    const float* in[24];
    float* out; unsigned char* ws;
};
#define INF(k) ((const float*)C.in[k])
enum { I_XP = 0, I_XS, I_CK, I_CV, I_CF, I_SG, I_SC, I_PT, I_GPM, I_WIN, I_BF, I_WA2, I_BA, I_GGLA, I_WPA, I_WPB, I_WOUT, I_GPOM, I_GPF, I_WUP, I_WCONV, I_BCONV, I_WDN, I_GPOF };

__device__ __forceinline__ void transpose_item(const float* W, int ldw, int c0, int ncols, int K, bf16* WT, int r0, LAS float* scr, int item, int lane) {
    const int nblk = (ncols + 31) / 32, kb = item / nblk, nb = item % nblk, k0 = 64 * kb, n0 = 32 * nb;
    const bool cok = (n0 + (lane & 31)) < ncols;
#pragma unroll 8
    for (int i = 0; i < 32; ++i) { const int kk = 2 * i + (lane >> 5); scr[kk * 33 + (lane & 31)] = cok ? W[(size_t)(k0 + kk) * ldw + c0 + n0 + (lane & 31)] : 0.f; }
    LDS_WAIT(); asm volatile("" ::: "memory");
    const int c = lane & 7;
#pragma unroll
    for (int j = 0; j < 4; ++j) { const int n = (lane >> 3) + 8 * j; const LAS float* s = scr + (8 * c) * 33 + n;
        v4u o; o.x = pk2(s[0 * 33], s[1 * 33]); o.y = pk2(s[2 * 33], s[3 * 33]); o.z = pk2(s[4 * 33], s[5 * 33]); o.w = pk2(s[6 * 33], s[7 * 33]);
        if (n0 + n < ncols) *(GAS v4u*)(WT + (size_t)(r0 + n0 + n) * K + k0 + 8 * c) = o; }
    LDS_WAIT(); asm volatile("" ::: "memory");
}
__device__ __forceinline__ void rms_row_to_bf16(const float* xrow, const float* g, bf16* orow, int lane) {
    const GAS f32x4* xr = (const GAS f32x4*)xrow + lane; const GAS f32x4* gr = (const GAS f32x4*)g + lane;
    f32x4 v[4]; float s = 0.f;
#pragma unroll
    for (int j = 0; j < 4; ++j) { v[j] = xr[64 * j]; s += (v[j].x * v[j].x + v[j].y * v[j].y) + (v[j].z * v[j].z + v[j].w * v[j].w); }
    const float r = 1.f / sqrtf(wave_sum(s) * (1.f / DM) + EPS);
    GAS unsigned long long* o8 = (GAS unsigned long long*)orow + lane;
#pragma unroll
    for (int j = 0; j < 4; ++j) { const f32x4 gg = gr[64 * j]; o8[64 * j] = (unsigned long long)pk2(v[j].x * r * gg.x, v[j].y * r * gg.y) | ((unsigned long long)pk2(v[j].z * r * gg.z, v[j].w * r * gg.w) << 32); }
}
__device__ __forceinline__ void p0_prologue(Ctx& C) {
    LAS float* scr = (LAS float*)(C.lds + RING_OFF + C.wave * 16384);
    const int gw = C.bid * NWAVES + C.wave, NGW = C.G * NWAVES;
    bf16* Win = (bf16*)(C.ws + WS_WIN);
#define SEG(c0, w, r0) { const int ni = (((w) + 31) / 32) * (DM / 64); for (int it = gw; it < ni; it += NGW) transpose_item(INF(I_WIN), DIN, (c0), (w), DM, Win, (r0), scr, it, C.lane); }
    SEG(0, 512, UC_QA) SEG(512, 512, UC_KA) SEG(1024, 512, UC_VA) SEG(1536, 8, UC_FA) SEG(1544, 512, UC_QB) SEG(2056, 512, UC_KB)
    SEG(2568, 1024, UC_VB) SEG(3592, 16, UC_AL) SEG(3608, 1024, UC_RB) SEG(4632, 1024, UC_GA) SEG(5656, 1024, UC_GB)
#undef SEG
    { const int ni = (DM / 32) * (AW / 64); for (int it = gw; it < ni; it += NGW) transpose_item(INF(I_WPA), DM, 0, DM, AW, (bf16*)(C.ws + WS_WPA), 0, scr, it, C.lane); }
    { const int ni = (DM / 32) * (BVW / 64); for (int it = gw; it < ni; it += NGW) transpose_item(INF(I_WPB), DM, 0, DM, BVW, (bf16*)(C.ws + WS_WPB), 0, scr, it, C.lane); }
    { const int ni = (DM / 32) * (DM / 64); for (int it = gw; it < ni; it += NGW) transpose_item(INF(I_WOUT), DM, 0, DM, DM, (bf16*)(C.ws + WS_WOUT), 0, scr, it, C.lane); }
    { const int ni = (DFF2 / 32) * (DM / 64); for (int it = gw; it < ni; it += NGW) transpose_item(INF(I_WUP), DFF2, 0, DFF2, DM, (bf16*)(C.ws + WS_WUP), 0, scr, it, C.lane); }
    { const int ni = (DM / 32) * (DFF / 64); for (int it = gw; it < ni; it += NGW) transpose_item(INF(I_WDN), DM, 0, DM, DFF, (bf16*)(C.ws + WS_WDN), 0, scr, it, C.lane); }
    { const int n16 = (NU - DIN) * DM * 2 / 16; GAS v4u* z = (GAS v4u*)(Win + (size_t)DIN * DM);
      for (int i = C.bid * NTHR + C.tid; i < n16; i += C.G * NTHR) z[i] = (v4u){0u, 0u, 0u, 0u}; }
    bf16* XN = (bf16*)(C.ws + WS_XN);
    for (int m = gw; m < MT; m += NGW) { const float* xr = m < MP ? INF(I_XP) + (size_t)m * DM : INF(I_XS) + (size_t)(m - MP) * DM; rms_row_to_bf16(xr, INF(I_GPM), XN + (size_t)m * DM, C.lane); }
}

__device__ __forceinline__ v4u pack8(f32x4 a, f32x4 b, float s) { v4u w; w.x = pg8::cvt_pk_bf16(a[0] * s, a[1] * s); w.y = pg8::cvt_pk_bf16(a[2] * s, a[3] * s); w.z = pg8::cvt_pk_bf16(b[0] * s, b[1] * s); w.w = pg8::cvt_pk_bf16(b[2] * s, b[3] * s); return w; }
struct StInProj {
    bf16* U; float* out; float* alow; float* fa;
    __device__ __forceinline__ void store8(int row, int col, int pn, f32x4 a, f32x4 b) const {
        if (pn == 26) {
            if (col == UC_FA) {
                float* dst = fa + (size_t)row * AH;
                *(f32x4*)dst = a; *(f32x4*)(dst + 4) = b;
            } else if (col == UC_AL || col == UC_AL + 8) {
                float* dst = alow + (size_t)row * GR + (col - UC_AL);
                *(f32x4*)dst = a; *(f32x4*)(dst + 4) = b;
            }
            return;
        }
        const float sc = pn < 2 ? C2 : ((pn == 6 || pn == 7) ? QB_SCALE : 1.f);
        *(v4u*)(U + (size_t)row * NU + col) = pack8(a, b, sc);
        if (pn >= 2 && pn < 6) {
            float* dst;
            if (pn < 4) dst = (row < MP ? out + OFF_KP + (size_t)row * AW : out + OFF_KS + (size_t)(row - MP) * AW) + (col - UC_KA);
            else        dst = (row < MP ? out + OFF_VP + (size_t)row * AW : out + OFF_VS + (size_t)(row - MP) * AW) + (col - UC_VA);
            *(f32x4*)dst = a; *(f32x4*)(dst + 4) = b;
        }
    }
};
struct StProjA {
    const bf16* U; float* TA;
    __device__ __forceinline__ void store8(int row, int col, int, f32x4 a, f32x4 b) const {
        const v4u g = *(const v4u*)(U + (size_t)row * NU + UC_GA + col);
        f32x4 x, y;
        x[0] = a[0] * sigmoidf_(bflo(g.x)); x[1] = a[1] * sigmoidf_(bfhi(g.x)); x[2] = a[2] * sigmoidf_(bflo(g.y)); x[3] = a[3] * sigmoidf_(bfhi(g.y));
        y[0] = b[0] * sigmoidf_(bflo(g.z)); y[1] = b[1] * sigmoidf_(bfhi(g.z)); y[2] = b[2] * sigmoidf_(bflo(g.w)); y[3] = b[3] * sigmoidf_(bfhi(g.w));
        float* dst = TA + (size_t)row * DM + col; *(f32x4*)dst = x; *(f32x4*)(dst + 4) = y;
    }
};
struct StProjB {
    const bf16* U; const float* TA; bf16* MG;
    __device__ __forceinline__ void store8(int row, int col, int, f32x4 a, f32x4 b) const {
        const v4u g = *(const v4u*)(U + (size_t)row * NU + UC_GB + col);
        const float* src = TA + (size_t)row * DM + col; const f32x4 t0 = *(const f32x4*)src, t1 = *(const f32x4*)(src + 4);
        f32x4 x, y;
        x[0] = t0[0] + a[0] * sigmoidf_(bflo(g.x)); x[1] = t0[1] + a[1] * sigmoidf_(bfhi(g.x)); x[2] = t0[2] + a[2] * sigmoidf_(bflo(g.y)); x[3] = t0[3] + a[3] * sigmoidf_(bfhi(g.y));
        y[0] = t1[0] + b[0] * sigmoidf_(bflo(g.z)); y[1] = t1[1] + b[1] * sigmoidf_(bfhi(g.z)); y[2] = t1[2] + b[2] * sigmoidf_(bflo(g.w)); y[3] = t1[3] + b[3] * sigmoidf_(bfhi(g.w));
        *(v4u*)(MG + (size_t)row * DM + col) = pack8(x, y, 1.f);
    }
};
struct StF32 {
    float* O;
    __device__ __forceinline__ void store8(int row, int col, int, f32x4 a, f32x4 b) const { float* dst = O + (size_t)row * DM + col; *(f32x4*)dst = a; *(f32x4*)(dst + 4) = b; }
};
struct StUp {
    bf16* UU; float* out;
    __device__ __forceinline__ void store8(int row, int col, int, f32x4 a, f32x4 b) const {
        *(v4u*)(UU + (size_t)row * DFF2 + col) = pack8(a, b, 1.f);
        float* dst = nullptr;
        if (row < MP) { const int t = row & (SEQ - 1); if (t >= SEQ - 2) dst = out + OFF_CP + ((size_t)(row >> 13) * 2 + (t - (SEQ - 2))) * DFF2 + col; }
        else { const int r = row - MP, t = r & 7; if (t >= 6) dst = out + OFF_CS + ((size_t)(r >> 3) * 2 + (t - 6)) * DFF2 + col; }
        if (dst) { *(f32x4*)dst = a; *(f32x4*)(dst + 4) = b; }
    }
};

__device__ __forceinline__ void p2_scans(Ctx& C) {
    LAS float* red = (LAS float*)(C.lds + RING_OFF);
    const int* pt = (const int*)C.in[I_PT];
    const int nunits = NB * AH + DB * AH;
    for (int u = C.bid; u < nunits; u += C.G) {
        float v[16]; float tot = 0.f;
        if (u < NB * AH) {
            const int b = u >> 3, h = u & 7; const float* src = (const float*)(C.ws + WS_FA) + ((size_t)b * SEQ + C.tid * 16) * AH + h;
            float* lo_ = C.out + OFF_FP + ((size_t)b * SEQ + C.tid * 16) * AH + h; const float bfh = INF(I_BF)[h];
#pragma unroll
            for (int i = 0; i < 16; ++i) { const float lf = logsigmoidf_(src[(size_t)i * AH] + bfh); lo_[(size_t)i * AH] = lf; tot += lf; v[i] = tot; }
        } else {
            const int db = (u - NB * AH) >> 3, h = u & 7; const int p0 = C.tid * 16; const int pg = pt[db * NPAGES + (p0 >> 7)];
            const float* src = INF(I_CF) + ((size_t)pg * PAGE + (p0 & 127)) * AH + h;
#pragma unroll
            for (int i = 15; i >= 0; --i) { v[i] = tot; tot += src[(size_t)i * AH]; }
        }
        __syncthreads();
        red[C.tid] = tot;
        __syncthreads();
        float pre = 0.f;
        if (u < NB * AH) { for (int i = 0; i < C.tid; ++i) pre += red[i]; }
        else { for (int i = NTHR - 1; i > C.tid; --i) pre += red[i]; }
        float* dst = u < NB * AH ? (float*)(C.ws + WS_CB) + (size_t)u * SEQ + C.tid * 16 : (float*)(C.ws + WS_SB) + (size_t)(u - NB * AH) * PAST + C.tid * 16;
        const float sgn = u < NB * AH ? -LOG2E : LOG2E;
#pragma unroll
        for (int i = 0; i < 16; i += 4) *(f32x4*)(dst + i) = (f32x4){(v[i] + pre) * sgn, (v[i + 1] + pre) * sgn, (v[i + 2] + pre) * sgn, (v[i + 3] + pre) * sgn};
    }
    if (C.bid == C.G - 1) for (int e = C.tid; e < MS * AH; e += NTHR) C.out[OFF_FS + e] = logsigmoidf_(((const float*)(C.ws + WS_FA))[(size_t)MP * AH + e] + INF(I_BF)[e & 7]);
    __syncthreads();
}

namespace att {
constexpr int LDS_K = 0, LDS_V = 8192, LDS_WS = 16384, LDS_OST = LDS_WS + 8 * 64 * 4, LDS_TOTAL = LDS_OST + 8 * 4096;
__device__ __forceinline__ int crow(int r, int hi) { return (r & 3) + 8 * (r >> 2) + 4 * hi; }
__device__ __forceinline__ void glds16(const void* gsrc, unsigned lds_dst) { unsigned keep;
    asm volatile("s_mov_b32 %0, m0\n\ts_mov_b32 m0, %2\n\ts_nop 0\n\tglobal_load_lds_dwordx4 %1, off\n\ts_mov_b32 m0, %0" : "=&s"(keep) : "v"(gsrc), "s"(lds_dst) : "memory"); }
typedef float f32x2_t __attribute__((ext_vector_type(2))); typedef __bf16 bf16x2_t __attribute__((ext_vector_type(2)));
__device__ __forceinline__ unsigned cvtpk_s(float lo, float hi) { f32x2_t v = {lo, hi}; bf16x2_t b = __builtin_convertvector(v, bf16x2_t); return __builtin_bit_cast(unsigned, b); }
__device__ __forceinline__ void pv(f32x16* o, int vb, bf16x8 pa0, bf16x8 pa1, bf16x8 pa2, bf16x8 pa3) {
#pragma unroll
    for (int d0 = 0; d0 < 2; ++d0) { s16x4 lo[4], hi[4];
#pragma unroll
        for (int ks = 0; ks < 4; ++ks) {
            asm volatile("ds_read_b64_tr_b16 %0,%1 offset:%c2" : "=&v"(lo[ks]) : "v"(vb), "i"(d0 * 4096 + ks * 1024) : "memory");
            asm volatile("ds_read_b64_tr_b16 %0,%1 offset:%c2" : "=&v"(hi[ks]) : "v"(vb), "i"(d0 * 4096 + ks * 1024 + 512) : "memory"); }
        asm volatile("s_waitcnt lgkmcnt(0)" ::: "memory"); __builtin_amdgcn_sched_barrier(0);
#define PK(k) (bf16x8){lo[k][0], lo[k][1], lo[k][2], lo[k][3], hi[k][0], hi[k][1], hi[k][2], hi[k][3]}
        o[d0] = __builtin_amdgcn_mfma_f32_32x32x16_bf16(pa0, PK(0), o[d0], 0, 0, 0);
        o[d0] = __builtin_amdgcn_mfma_f32_32x32x16_bf16(pa1, PK(1), o[d0], 0, 0, 0);
        o[d0] = __builtin_amdgcn_mfma_f32_32x32x16_bf16(pa2, PK(2), o[d0], 0, 0, 0);
        o[d0] = __builtin_amdgcn_mfma_f32_32x32x16_bf16(pa3, PK(3), o[d0], 0, 0, 0);
#undef PK
    }
}
__device__ __forceinline__ void attn_unit(int b, int h, int qb, const bf16* U, const float* CB, bf16* OA, LAS unsigned char* shm) {
    const int tid = threadIdx.x, lane = tid & 63, r32 = lane & 31, hi = lane >> 5; const int wid = __builtin_amdgcn_readfirstlane(tid >> 6);
    const long rowbase = (long)b * SEQ; const int q0 = qb * 256;
    const bf16* Qw = U + (rowbase + q0 + wid * 32) * NU + UC_QA + h * 64;
    const bf16* Kh = U + rowbase * NU + UC_KA + h * 64; const bf16* Vh = U + rowbase * NU + UC_VA + h * 64;
    const float* CBh = CB + (size_t)(b * AH + h) * SEQ;
    const unsigned lds0 = (unsigned)(uintptr_t)shm;
    LAS float* wsf = (LAS float*)(shm + LDS_WS) + wid * 64;
    const bf16* ksrc = Kh + (long)lane * NU + wid * 8;
    const bf16* vsrc = Vh + (long)(16 * (wid & 3) + (lane >> 2)) * NU + (wid >> 2) * 32 + (lane & 3) * 8;
    const unsigned kdst = lds0 + LDS_K + wid * 1024, vdst = lds0 + LDS_V + wid * 1024;
    const int vb0 = (int)(lds0 + LDS_V) + ((lane >> 4) & 1) * 32 + (lane & 3) * 8 + (4 * hi + ((lane & 15) >> 2)) * 64;
    const LAS unsigned char* kp0 = shm + LDS_K + hi * 1024 + r32 * 16;
    const int NT = (q0 + 256) / 64;
    bf16x8 qr[4];
#pragma unroll
    for (int d0 = 0; d0 < 4; ++d0) qr[d0] = *(const bf16x8*)(Qw + (long)r32 * NU + d0 * 16 + hi * 8);
    float mrun = -INFINITY, lsum = 0.f; f32x16 o[2]; o[0] = f32x16{}; o[1] = f32x16{};
    const int qrel = wid * 32 + r32;
    for (int t = 0; t < NT; ++t) {
        glds16(ksrc + (long)t * 64 * NU, (unsigned)__builtin_amdgcn_readfirstlane(kdst));
        glds16(vsrc + (long)t * 64 * NU, (unsigned)__builtin_amdgcn_readfirstlane(vdst));
        f32x16 p0, p1;
#pragma unroll
        for (int g = 0; g < 4; ++g) { const f32x4 c0 = *(const f32x4*)(CBh + t * 64 + 8 * g + 4 * hi), c1 = *(const f32x4*)(CBh + t * 64 + 32 + 8 * g + 4 * hi);
            p0[4 * g] = c0[0]; p0[4 * g + 1] = c0[1]; p0[4 * g + 2] = c0[2]; p0[4 * g + 3] = c0[3]; p1[4 * g] = c1[0]; p1[4 * g + 1] = c1[1]; p1[4 * g + 2] = c1[2]; p1[4 * g + 3] = c1[3]; }
        asm volatile("s_waitcnt vmcnt(0) lgkmcnt(0)\n\ts_barrier" ::: "memory");
#pragma unroll
        for (int d0 = 0; d0 < 4; ++d0) {
            const bf16x8 k0 = *(const LAS bf16x8*)(kp0 + d0 * 2048), k1 = *(const LAS bf16x8*)(kp0 + d0 * 2048 + 512);
            p0 = __builtin_amdgcn_mfma_f32_32x32x16_bf16(k0, qr[d0], p0, 0, 0, 0);
            p1 = __builtin_amdgcn_mfma_f32_32x32x16_bf16(k1, qr[d0], p1, 0, 0, 0);
        }
        const int jb = t - (NT - 4);
        if (jb >= 0) { const int kb = 64 * jb + 4 * hi;
#pragma unroll
            for (int r = 0; r < 16; ++r) { const int kv = kb + (r & 3) + 8 * (r >> 2); if (kv > qrel) p0[r] = -INFINITY; if (kv + 32 > qrel) p1[r] = -INFINITY; } }
        float rm = p0[0];
#pragma unroll
        for (int r = 1; r < 16; ++r) rm = fmaxf(rm, p0[r]);
#pragma unroll
        for (int r = 0; r < 16; ++r) rm = fmaxf(rm, p1[r]);
        { auto rr = __builtin_amdgcn_permlane32_swap(__float_as_uint(rm), __float_as_uint(rm), false, false); rm = fmaxf(__uint_as_float(rr[0]), __uint_as_float(rr[1])); }
        const float mn = fmaxf(mrun, rm);
        const float f = __builtin_amdgcn_exp2f(mrun - mn); mrun = mn;
        float sacc = 0.f;
#pragma unroll
        for (int r = 0; r < 16; ++r) { p0[r] = __builtin_amdgcn_exp2f(p0[r] - mn); p1[r] = __builtin_amdgcn_exp2f(p1[r] - mn); sacc += p0[r] + p1[r]; }
        lsum = lsum * f + sacc;
        if (hi == 0) wsf[r32] = f;
        asm volatile("s_waitcnt lgkmcnt(0)" ::: "memory");
#pragma unroll
        for (int r = 0; r < 16; ++r) { const float fr = wsf[crow(r, hi)]; o[0][r] *= fr; o[1][r] *= fr; }
        v4u pw0, pw1, pw2, pw3;
        pw0 = (v4u){cvtpk_s(p0[0], p0[1]), cvtpk_s(p0[2], p0[3]), cvtpk_s(p0[4], p0[5]), cvtpk_s(p0[6], p0[7])};
        pw1 = (v4u){cvtpk_s(p0[8], p0[9]), cvtpk_s(p0[10], p0[11]), cvtpk_s(p0[12], p0[13]), cvtpk_s(p0[14], p0[15])};
        pw2 = (v4u){cvtpk_s(p1[0], p1[1]), cvtpk_s(p1[2], p1[3]), cvtpk_s(p1[4], p1[5]), cvtpk_s(p1[6], p1[7])};
        pw3 = (v4u){cvtpk_s(p1[8], p1[9]), cvtpk_s(p1[10], p1[11]), cvtpk_s(p1[12], p1[13]), cvtpk_s(p1[14], p1[15])};
        __builtin_amdgcn_sched_barrier(0);
        pv(o, vb0, __builtin_bit_cast(bf16x8, pw0), __builtin_bit_cast(bf16x8, pw1), __builtin_bit_cast(bf16x8, pw2), __builtin_bit_cast(bf16x8, pw3));
        asm volatile("s_waitcnt lgkmcnt(0)\n\ts_barrier" ::: "memory");
    }
    { auto rr = __builtin_amdgcn_permlane32_swap(__float_as_uint(lsum), __float_as_uint(lsum), false, false); lsum = __uint_as_float(rr[0]) + __uint_as_float(rr[1]); }
    if (hi == 0) wsf[32 + r32] = lsum;
    asm volatile("s_waitcnt lgkmcnt(0)" ::: "memory");
    float rli[16];
#pragma unroll
    for (int r = 0; r < 16; ++r) rli[r] = __builtin_amdgcn_rcpf(wsf[32 + crow(r, hi)]);
    bf16* Ow = OA + (rowbase + q0 + wid * 32) * AW + h * 64;
    { LAS bf16* stg = (LAS bf16*)(shm + LDS_OST) + wid * 2048;
#pragma unroll
        for (int r = 0; r < 16; ++r) { const int orow = crow(r, hi);
#pragma unroll
            for (int d0 = 0; d0 < 2; ++d0) stg[orow * 64 + d0 * 32 + r32] = (bf16)(cvtpk_s(o[d0][r] * rli[r], 0.f) & 0xffffu); }
        asm volatile("s_waitcnt lgkmcnt(0)" ::: "memory");
#pragma unroll
        for (int i = 0; i < 4; ++i) { const int row = i * 8 + (lane >> 3), ch = lane & 7; const v4u v = *(const LAS v4u*)(stg + row * 64 + ch * 8); *(v4u*)(Ow + (long)row * AW + ch * 8) = v; } }
    asm volatile("s_waitcnt lgkmcnt(0)\n\ts_barrier" ::: "memory");
}
}

__device__ __forceinline__ void sattn_unit(Ctx& C, int db, int rg) {
    const int lane = C.lane, h = C.wave, q = lane & 15, fq = lane >> 4;
    const bf16* U = (const bf16*)(C.ws + WS_U);
    const int* pt = (const int*)C.in[I_PT];
    const float* SBh = (const float*)(C.ws + WS_SB) + (size_t)(db * AH + h) * PAST + rg * 1024;
    float qf[4][4];
    { const bf16* qrow = U + (size_t)(MP + db * DS + (q & 7)) * NU + UC_QA + h * 64;
#pragma unroll
      for (int m = 0; m < 4; ++m) { const v2u w = *(const v2u*)(qrow + (4 * m + fq) * 4);
          qf[m][0] = q < 8 ? bflo(w.x) : 0.f; qf[m][1] = q < 8 ? bfhi(w.x) : 0.f; qf[m][2] = q < 8 ? bflo(w.y) : 0.f; qf[m][3] = q < 8 ? bfhi(w.y) : 0.f; } }
    float mrun = -INFINITY, lsum = 0.f; f32x4 o[4];
#pragma unroll
    for (int j = 0; j < 4; ++j) o[j] = (f32x4){0.f, 0.f, 0.f, 0.f};
    for (int blk = 0; blk < 64; ++blk) {
        const int pg = pt[db * NPAGES + rg * 8 + (blk >> 3)]; const size_t tok0 = (size_t)pg * PAGE + (blk & 7) * 16;
        const float* Kb = INF(I_CK) + tok0 * AW + h * 64; const float* Vb = INF(I_CV) + tok0 * AW + h * 64;
        f32x4 kk[4], vv[4];
#pragma unroll
        for (int m = 0; m < 4; ++m) kk[m] = *(const f32x4*)(Kb + (size_t)q * AW + (4 * m + fq) * 4);
#pragma unroll
        for (int r4 = 0; r4 < 4; ++r4) vv[r4] = *(const f32x4*)(Vb + (size_t)(4 * fq + r4) * AW + q * 4);
        f32x4 s = *(const f32x4*)(SBh + blk * 16 + 4 * fq);
#pragma unroll
        for (int m = 0; m < 4; ++m)
#pragma unroll
            for (int j = 0; j < 4; ++j) s = __builtin_amdgcn_mfma_f32_16x16x4f32(kk[m][j], qf[m][j], s, 0, 0, 0);
        float rm = fmaxf(fmaxf(s[0], s[1]), fmaxf(s[2], s[3]));
        rm = fmaxf(rm, __shfl_xor(rm, 16)); rm = fmaxf(rm, __shfl_xor(rm, 32));
        const float mn = fmaxf(mrun, rm); const float f = __builtin_amdgcn_exp2f(mrun - mn); mrun = mn;
        f32x4 p;
#pragma unroll
        for (int i = 0; i < 4; ++i) p[i] = __builtin_amdgcn_exp2f(s[i] - mn);
        lsum = lsum * f + (p[0] + p[1]) + (p[2] + p[3]);
#pragma unroll
        for (int j = 0; j < 4; ++j) o[j] = o[j] * f;
#pragma unroll
        for (int r4 = 0; r4 < 4; ++r4)
#pragma unroll
            for (int j = 0; j < 4; ++j) o[j] = __builtin_amdgcn_mfma_f32_16x16x4f32(vv[r4][j], p[r4], o[j], 0, 0, 0);
    }
    lsum += __shfl_xor(lsum, 16); lsum += __shfl_xor(lsum, 32);
    if (q < 8) {
        float* dst = (float*)(C.ws + WS_PART) + ((size_t)((db * 8 + rg) * AH + h) * DS + q) * PART_STRIDE;
        if (fq == 0) { dst[0] = mrun; dst[1] = lsum; }
#pragma unroll
        for (int j = 0; j < 4; ++j)
#pragma unroll
            for (int r = 0; r < 4; ++r) dst[4 + 4 * (4 * fq + r) + j] = o[j][r];
    }
}
__device__ __forceinline__ void sattn_combine(Ctx& C) {
    const bf16* U = (const bf16*)(C.ws + WS_U); bf16* OA = (bf16*)(C.ws + WS_OA);
    const int gw = C.bid * NWAVES + C.wave, NGW = C.G * NWAVES, d = C.lane;
    for (int it = gw; it < DB * AH * DS; it += NGW) {
        const int db = it >> 6, h = (it >> 3) & 7, q = it & 7;
        const float qd = bf2f(U[(size_t)(MP + db * DS + q) * NU + UC_QA + h * 64 + d]);
        float sn[8]; float cn = 0.f; float M = -INFINITY;
#pragma unroll
        for (int j = 0; j < 8; ++j) {
            cn += C.out[OFF_FS + (size_t)(db * DS + j) * AH + h];
            const float kd = C.out[OFF_KS + (size_t)(db * DS + j) * AW + h * 64 + d];
            const float s = wave_sum(qd * kd) - cn * LOG2E;
            sn[j] = j <= q ? s : -INFINITY; M = fmaxf(M, sn[j]);
        }
        float pm[8], pl[8];
#pragma unroll
        for (int r = 0; r < 8; ++r) { const float* src = (const float*)(C.ws + WS_PART) + ((size_t)((db * 8 + r) * AH + h) * DS + q) * PART_STRIDE; pm[r] = src[0]; pl[r] = src[1]; M = fmaxf(M, pm[r]); }
        float L = 0.f, O = 0.f;
#pragma unroll
        for (int r = 0; r < 8; ++r) { const float* src = (const float*)(C.ws + WS_PART) + ((size_t)((db * 8 + r) * AH + h) * DS + q) * PART_STRIDE; const float w = __builtin_amdgcn_exp2f(pm[r] - M); L += pl[r] * w; O += src[4 + d] * w; }
#pragma unroll
        for (int j = 0; j < 8; ++j) { const float w = __builtin_amdgcn_exp2f(sn[j] - M); L += w; O += w * C.out[OFF_VS + (size_t)(db * DS + j) * AW + h * 64 + d]; }
        OA[(size_t)(MP + db * DS + q) * AW + h * 64 + d] = (bf16)f2bf(O / L);
    }
}

__device__ __forceinline__ void gla_unit(Ctx& C, int seq, int h, int sl) {
    LAS float* W2h = (LAS float*)(C.lds + RING_OFF);
    LAS float* BAl = W2h + 2048;
    LAS float* ALB = BAl + 128;
    LAS float* QS = ALB + 512;
    LAS float* KS = QS + 4096;
    LAS float* AL = KS + 4096;
    LAS float* VV = AL + 4096;
    LAS float* OP = VV + 1024;
    const bf16* U = (const bf16*)(C.ws + WS_U); const float* alow = (const float*)(C.ws + WS_ALOW); float* OBR = (float*)(C.ws + WS_OBR);
    const int tid = C.tid, v = tid & 31, isl = tid >> 5;
    const int T = seq < NB ? SEQ : DS; const int row0 = seq < NB ? seq * SEQ : MP + (seq - NB) * DS;
    __syncthreads();
    for (int e = tid; e < 2048; e += NTHR) W2h[e] = INF(I_WA2)[(e >> 7) * BKW + h * 128 + (e & 127)];
    if (tid < 128) BAl[tid] = INF(I_BA)[h * 128 + tid];
    float S[8];
    float* stout = seq < NB ? C.out + OFF_GP + ((size_t)(seq * BH + h) * BK_) * BV + sl * 32 + v : C.out + OFF_GS + ((size_t)((seq - NB) * BH + h) * BK_) * BV + sl * 32 + v;
#pragma unroll
    for (int j = 0; j < 8; ++j) S[j] = seq < NB ? 0.f : INF(I_SG)[((size_t)((seq - NB) * BH + h) * BK_ + isl * 8 + j) * BV + sl * 32 + v];
    for (int blk0 = 0; blk0 < T; blk0 += 32) {
        const int nb = (T - blk0) < 32 ? (T - blk0) : 32;
        __syncthreads();
        if (tid < nb * 16) ALB[tid] = alow[(size_t)(row0 + blk0) * GR + tid];
        for (int e = tid; e < nb * 32; e += NTHR) VV[e] = bf2f(U[(size_t)(row0 + blk0 + (e >> 5)) * NU + UC_VB + h * 256 + sl * 32 + (e & 31)]);
        __syncthreads();
#pragma unroll
        for (int n = 0; n < 8; ++n) { const int e = tid + NTHR * n, t = e >> 7, i = e & 127;
            if (t < nb) { float x = BAl[i];
#pragma unroll
                for (int r = 0; r < 16; ++r) x += ALB[t * 16 + r] * W2h[r * 128 + i];
                AL[e] = expf(logsigmoidf_(x) * (1.f / 16.f));
                const size_t ro = (size_t)(row0 + blk0 + t) * NU;
                QS[e] = bf2f(U[ro + UC_QB + h * 128 + i]); KS[e] = bf2f(U[ro + UC_KB + h * 128 + i]); } }
        __syncthreads();
        for (int t = 0; t < nb; ++t) {
            const float vt = VV[t * 32 + v];
            const f32x4 a0 = *(const LAS f32x4*)(AL + t * 128 + isl * 8), a1 = *(const LAS f32x4*)(AL + t * 128 + isl * 8 + 4);
            const f32x4 k0 = *(const LAS f32x4*)(KS + t * 128 + isl * 8), k1 = *(const LAS f32x4*)(KS + t * 128 + isl * 8 + 4);
            const f32x4 q0 = *(const LAS f32x4*)(QS + t * 128 + isl * 8), q1 = *(const LAS f32x4*)(QS + t * 128 + isl * 8 + 4);
            float oo = 0.f;
#pragma unroll
            for (int j = 0; j < 4; ++j) { S[j] = a0[j] * S[j] + k0[j] * vt; oo += q0[j] * S[j]; S[4 + j] = a1[j] * S[4 + j] + k1[j] * vt; oo += q1[j] * S[4 + j]; }
            oo += __shfl_xor(oo, 32);
            if (C.lane < 32) OP[(t * 8 + C.wave) * 32 + v] = oo;
        }
        __syncthreads();
        for (int e = tid; e < nb * 32; e += NTHR) { const int t = e >> 5, vv = e & 31; float s = 0.f;
#pragma unroll
            for (int w = 0; w < 8; ++w) s += OP[(t * 8 + w) * 32 + vv];
            OBR[(size_t)(row0 + blk0 + t) * BVW + h * 256 + sl * 32 + vv] = s; }
    }
#pragma unroll
    for (int j = 0; j < 8; ++j) stout[(size_t)(isl * 8 + j) * BV] = S[j];
    __syncthreads();
}
__device__ __forceinline__ void gla_post(Ctx& C) {
    const bf16* U = (const bf16*)(C.ws + WS_U); const float* OBR = (const float*)(C.ws + WS_OBR); bf16* OB = (bf16*)(C.ws + WS_OB);
    const int gw = C.bid * NWAVES + C.wave, NGW = C.G * NWAVES;
    const f32x4 gg = *(const f32x4*)(INF(I_GGLA) + C.lane * 4);
    for (int m = gw; m < MT; m += NGW) {
#pragma unroll
        for (int h = 0; h < 4; ++h) {
            const f32x4 x = *(const f32x4*)(OBR + (size_t)m * BVW + h * 256 + C.lane * 4);
            const float r = 1.f / sqrtf(wave_sum((x[0] * x[0] + x[1] * x[1]) + (x[2] * x[2] + x[3] * x[3])) * (1.f / 256.f) + EPS);
            const v2u rb = *(const v2u*)(U + (size_t)m * NU + UC_RB + h * 256 + C.lane * 4);
            const float r0 = bflo(rb.x), r1 = bfhi(rb.x), r2 = bflo(rb.y), r3 = bfhi(rb.y);
            v2u w; w.x = pk2(x[0] * r * gg[0] * r0 * sigmoidf_(r0), x[1] * r * gg[1] * r1 * sigmoidf_(r1)); w.y = pk2(x[2] * r * gg[2] * r2 * sigmoidf_(r2), x[3] * r * gg[3] * r3 * sigmoidf_(r3));
            *(v2u*)(OB + (size_t)m * BVW + h * 256 + C.lane * 4) = w;
        }
    }
}

__device__ __forceinline__ void p7_rows(Ctx& C) {
    const float* F1 = (const float*)(C.ws + WS_F1); float* X1 = (float*)(C.ws + WS_X1); bf16* XN2 = (bf16*)(C.ws + WS_XN2);
    const int gw = C.bid * NWAVES + C.wave, NGW = C.G * NWAVES, lane = C.lane;
    for (int m = gw; m < MT; m += NGW) {
        const float* xr = m < MP ? INF(I_XP) + (size_t)m * DM : INF(I_XS) + (size_t)(m - MP) * DM;
        f32x4 f[4], x[4]; float s = 0.f;
#pragma unroll
        for (int j = 0; j < 4; ++j) { f[j] = *((const f32x4*)(F1 + (size_t)m * DM) + lane + 64 * j); x[j] = *((const f32x4*)xr + lane + 64 * j); s += (f[j].x * f[j].x + f[j].y * f[j].y) + (f[j].z * f[j].z + f[j].w * f[j].w); }
        const float r = 1.f / sqrtf(wave_sum(s) * (1.f / DM) + EPS); float s2 = 0.f;
#pragma unroll
        for (int j = 0; j < 4; ++j) { const f32x4 g = *((const f32x4*)INF(I_GPOM) + lane + 64 * j); x[j] = x[j] + f[j] * r * g; s2 += (x[j].x * x[j].x + x[j].y * x[j].y) + (x[j].z * x[j].z + x[j].w * x[j].w);
            *((f32x4*)(X1 + (size_t)m * DM) + lane + 64 * j) = x[j]; }
        const float r2 = 1.f / sqrtf(wave_sum(s2) * (1.f / DM) + EPS);
#pragma unroll
        for (int j = 0; j < 4; ++j) { const f32x4 g = *((const f32x4*)INF(I_GPF) + lane + 64 * j); v2u w; w.x = pk2(x[j].x * r2 * g.x, x[j].y * r2 * g.y); w.y = pk2(x[j].z * r2 * g.z, x[j].w * r2 * g.w);
            *((v2u*)(XN2 + (size_t)m * DM) + lane + 64 * j) = w; }
    }
}
__device__ __forceinline__ void p11_rows(Ctx& C) {
    const float* F2 = (const float*)(C.ws + WS_F2); const float* X1 = (const float*)(C.ws + WS_X1);
    const int gw = C.bid * NWAVES + C.wave, NGW = C.G * NWAVES, lane = C.lane;
    for (int m = gw; m < MT; m += NGW) {
        f32x4 f[4]; float s = 0.f;
#pragma unroll
        for (int j = 0; j < 4; ++j) { f[j] = *((const f32x4*)(F2 + (size_t)m * DM) + lane + 64 * j); s += (f[j].x * f[j].x + f[j].y * f[j].y) + (f[j].z * f[j].z + f[j].w * f[j].w); }
        const float r = 1.f / sqrtf(wave_sum(s) * (1.f / DM) + EPS);
#pragma unroll
        for (int j = 0; j < 4; ++j) { const f32x4 g = *((const f32x4*)INF(I_GPOF) + lane + 64 * j); const f32x4 x = *((const f32x4*)(X1 + (size_t)m * DM) + lane + 64 * j);
            *((f32x4*)(C.out + OFF_YP + (size_t)m * DM) + lane + 64 * j) = x + f[j] * r * g; }
    }
}
__device__ __forceinline__ float gelu_tanh(float g) { const float u = 0.7978845608028654f * (g + 0.044715f * g * g * g); const float e = __expf(2.f * u); const float th = 1.f - 2.f / (e + 1.f); return 0.5f * g * (1.f + th); }
__device__ __forceinline__ void p9_conv(Ctx& C) {
    const bf16* UU = (const bf16*)(C.ws + WS_UU); bf16* ACT = (bf16*)(C.ws + WS_ACT);
    const float* wc = INF(I_WCONV); const float* bc = INF(I_BCONV);
    constexpr int NG = DFF / 8;
    const long total = (long)MT * NG;
    for (long it = (long)C.bid * NTHR + C.tid; it < total; it += (long)C.G * NTHR) {
        const int m = (int)(it / NG), j0 = (int)(it % NG) * 8;
        int t; const float* sc = nullptr;
        if (m < MP) t = m & (SEQ - 1); else { t = (m - MP) & 7; sc = INF(I_SC) + (size_t)((m - MP) >> 3) * 2 * DFF2; }
        float res[2][8];
#pragma unroll
        for (int half = 0; half < 2; ++half) {
            const int c0 = half * DFF + j0;
            float acc[8];
#pragma unroll
            for (int i = 0; i < 8; ++i) acc[i] = bc[c0 + i];
#pragma unroll
            for (int k = 0; k < 3; ++k) {
                const int tt = t - 2 + k; float xv[8];
                if (tt >= 0) { const v4u w = *(const v4u*)(UU + (size_t)(m - 2 + k) * DFF2 + c0);
                    xv[0] = bflo(w.x); xv[1] = bfhi(w.x); xv[2] = bflo(w.y); xv[3] = bfhi(w.y); xv[4] = bflo(w.z); xv[5] = bfhi(w.z); xv[6] = bflo(w.w); xv[7] = bfhi(w.w); }
                else if (sc) { const float* s = sc + (size_t)(tt + 2) * DFF2 + c0;
#pragma unroll
                    for (int i = 0; i < 8; ++i) xv[i] = s[i]; }
                else {
#pragma unroll
                    for (int i = 0; i < 8; ++i) xv[i] = 0.f; }
#pragma unroll
                for (int i = 0; i < 8; ++i) acc[i] += xv[i] * wc[(size_t)k * DFF2 + c0 + i];
            }
#pragma unroll
            for (int i = 0; i < 8; ++i) res[half][i] = acc[i];
        }
        v4u w;
        w.x = pk2(gelu_tanh(res[1][0]) * res[0][0], gelu_tanh(res[1][1]) * res[0][1]); w.y = pk2(gelu_tanh(res[1][2]) * res[0][2], gelu_tanh(res[1][3]) * res[0][3]);
        w.z = pk2(gelu_tanh(res[1][4]) * res[0][4], gelu_tanh(res[1][5]) * res[0][5]); w.w = pk2(gelu_tanh(res[1][6]) * res[0][6], gelu_tanh(res[1][7]) * res[0][7]);
        *(v4u*)(ACT + (size_t)m * DFF + j0) = w;
    }
}

constexpr int NPHASE = 13;
struct Args { const void* in[24]; float* out; unsigned char* ws; int ph_lo, ph_hi; };
__global__ void __launch_bounds__(NTHR, 2) mk_fwd(Args args) {
    extern __shared__ __attribute__((aligned(16))) unsigned char lds[];
    Ctx C;
    C.lds = (LAS unsigned char*)lds;
    C.tid = threadIdx.x; C.lane = C.tid & 63; C.wave = __builtin_amdgcn_readfirstlane(C.tid >> 6);
    C.G = gridDim.x; C.bid = blockIdx.x;
#pragma unroll
    for (int i = 0; i < 24; ++i) C.in[i] = (const float*)args.in[i];
    C.out = args.out; C.ws = args.ws;
    unsigned char* ws = args.ws;
    for (int u = C.tid; u < (LDS_BYTES - LDSCTL_OFF) / 4; u += NTHR) ((LAS unsigned*)(C.lds + LDSCTL_OFF))[u] = 0u;
    __syncthreads();
    const int lo = args.ph_lo, hi = args.ph_hi;
    const bool multi = (hi - lo) > 1;
    XcdBarrier bar; bar.bar = (unsigned*)(ws + WS_CTL) + CW_BAR; bar.x = 0; bar.st = nullptr;
    if (multi) bar = xcd_barrier_post((unsigned*)(ws + WS_CTL) + CW_BAR, (volatile LAS unsigned*)(C.lds + MISC_OFF) + 8);
#ifndef PHASE_MASK
#define PHASE_MASK 0xFFFF
#endif
#define IN(k) (((PHASE_MASK >> (k)) & 1) && lo <= (k) && (k) < hi)
#define SEAM(k) do { if (IN(k) && IN((k) + 1)) xcd_barrier(bar); } while (0)
    bf16* U = (bf16*)(ws + WS_U);

    if (IN(0)) { p0_prologue(C); } SEAM(0);

    if (IN(1)) {
        pg8::Gemm g{(const bf16*)(ws + WS_XN), (const bf16*)(ws + WS_WIN), MT, NU, DM}; pg8::StaticOrder S; S.init(MT, NU, C.G, C.bid);
        pg8::EpiGen<StInProj> E{{U, C.out, (float*)(ws + WS_ALOW), (float*)(ws + WS_FA)}};
        pg8::gemm_phase<pg8::EpiGen<StInProj>, pg8::StaticOrder, true, true>(C.lds + RING_OFF, g, S, E);
    } SEAM(1);

    if (IN(2)) { p2_scans(C); } SEAM(2);

    if (IN(3)) {
        const int NGLA = C.G >= 128 ? 64 : 0;
        if (C.bid < NGLA) {
            for (int u = C.bid; u < NB * BH * 8 + DB * BH * 8; u += NGLA) {
                int seq, h, sl; if (u < 64) { seq = u >> 5; h = (u >> 3) & 3; sl = u & 7; } else { const int w = u - 64; seq = NB + (w >> 5); h = (w >> 3) & 3; sl = w & 7; }
                gla_unit(C, seq, h, sl);
            }
        } else {
            const int nw = C.G - NGLA, me = C.bid - NGLA;
            for (int u = me; u < 512 + 256; u += nw) {
                if (u < 512) { const int qb = 31 - (u >> 4), bh = u & 15; att::attn_unit(bh >> 3, bh & 7, qb, U, (const float*)(ws + WS_CB), (bf16*)(ws + WS_OA), C.lds + RING_OFF); }
                else { const int w = u - 512; sattn_unit(C, w >> 3, w & 7); }
            }
            if (NGLA == 0) for (int u = C.bid; u < NB * BH * 8 + DB * BH * 8; u += C.G) {
                int seq, h, sl; if (u < 64) { seq = u >> 5; h = (u >> 3) & 3; sl = u & 7; } else { const int w = u - 64; seq = NB + (w >> 5); h = (w >> 3) & 3; sl = w & 7; }
                gla_unit(C, seq, h, sl);
            }
        }
    } SEAM(3);

    if (IN(4)) { sattn_combine(C); gla_post(C); } SEAM(4);

    if (IN(5)) {
        pg8::Gemm g{(const bf16*)(ws + WS_OA), (const bf16*)(ws + WS_WPA), MT, DM, AW}; pg8::StaticOrder S; S.init(MT, DM, C.G, C.bid);
        pg8::EpiGen<StProjA> E{{U, (float*)(ws + WS_TA)}};
        pg8::gemm_phase<pg8::EpiGen<StProjA>, pg8::StaticOrder, true, true>(C.lds + RING_OFF, g, S, E);
    } SEAM(5);

    if (IN(6)) {
        pg8::Gemm g{(const bf16*)(ws + WS_OB), (const bf16*)(ws + WS_WPB), MT, DM, BVW}; pg8::StaticOrder S; S.init(MT, DM, C.G, C.bid);
        pg8::EpiGen<StProjB> E{{U, (const float*)(ws + WS_TA), (bf16*)(ws + WS_MG)}};
        pg8::gemm_phase<pg8::EpiGen<StProjB>, pg8::StaticOrder, true, true>(C.lds + RING_OFF, g, S, E);
    } SEAM(6);

    if (IN(7)) {
        pg8::Gemm g{(const bf16*)(ws + WS_MG), (const bf16*)(ws + WS_WOUT), MT, DM, DM}; pg8::StaticOrder S; S.init(MT, DM, C.G, C.bid);
        pg8::EpiGen<StF32> E{{(float*)(ws + WS_F1)}};
        pg8::gemm_phase<pg8::EpiGen<StF32>, pg8::StaticOrder, true, true>(C.lds + RING_OFF, g, S, E);
    } SEAM(7);

    if (IN(8)) { p7_rows(C); } SEAM(8);

    if (IN(9)) {
        pg8::Gemm g{(const bf16*)(ws + WS_XN2), (const bf16*)(ws + WS_WUP), MT, DFF2, DM}; pg8::StaticOrder S; S.init(MT, DFF2, C.G, C.bid);
        pg8::EpiGen<StUp> E{{(bf16*)(ws + WS_UU), C.out}};
        pg8::gemm_phase<pg8::EpiGen<StUp>, pg8::StaticOrder, true, true>(C.lds + RING_OFF, g, S, E);
    } SEAM(9);

    if (IN(10)) { p9_conv(C); } SEAM(10);

    if (IN(11)) {
        pg8::Gemm g{(const bf16*)(ws + WS_ACT), (const bf16*)(ws + WS_WDN), MT, DM, DFF}; pg8::StaticOrder S; S.init(MT, DM, C.G, C.bid);
        pg8::EpiGen<StF32> E{{(float*)(ws + WS_F2)}};
        pg8::gemm_phase<pg8::EpiGen<StF32>, pg8::StaticOrder, true, true>(C.lds + RING_OFF, g, S, E);
    } SEAM(11);

    if (IN(12)) { p11_rows(C); }
#undef IN
#undef SEAM
}

#ifndef MK_SPLIT
#define MK_SPLIT 0
#endif
extern "C" void kernel_launch(void* const* d_in, const int* in_sizes, int n_in, void* d_out, int out_size, void* d_ws, size_t ws_size, hipStream_t stream) {
    static int grid = 0;
    if (grid == 0) {
        if (n_in != 24 || (size_t)out_size != OUT_TOTAL || ws_size < WS_END) { fprintf(stderr, "kernel_launch: unexpected problem (n_in %d, out %d, ws %zu)\n", n_in, out_size, ws_size); grid = -1; return; }
        int dev = 0, cus = 0, per_cu = 0;
        if (hipGetDevice(&dev) != hipSuccess || hipDeviceGetAttribute(&cus, hipDeviceAttributeMultiprocessorCount, dev) != hipSuccess) { grid = -1; return; }
        if (hipFuncSetAttribute((const void*)mk_fwd, hipFuncAttributeMaxDynamicSharedMemorySize, LDS_BYTES) != hipSuccess) { fprintf(stderr, "kernel_launch: hipFuncSetAttribute failed\n"); grid = -1; return; }
        if (hipOccupancyMaxActiveBlocksPerMultiprocessor(&per_cu, (const void*)mk_fwd, NTHR, LDS_BYTES) != hipSuccess || per_cu < 1) fprintf(stderr, "kernel_launch: occupancy query reports %d\n", per_cu);
        (void)hipGetLastError();
        grid = cus;
    }
    if (grid < 0) return;
    if (hipMemsetAsync((char*)d_ws + WS_CTL, 0, CTL_ZERO_BYTES, stream) != hipSuccess) return;
    Args a{};
    for (int i = 0; i < 24; ++i) a.in[i] = d_in[i];
    a.out = (float*)d_out; a.ws = (unsigned char*)d_ws;
#if MK_SPLIT
    for (int p = 0; p < NPHASE; ++p) { a.ph_lo = p; a.ph_hi = p + 1; hipLaunchKernelGGL(mk_fwd, dim3(grid), dim3(NTHR), LDS_BYTES, stream, a); }
#else
    a.ph_lo = 0; a.ph_hi = NPHASE;
    hipLaunchKernelGGL(mk_fwd, dim3(grid), dim3(NTHR), LDS_BYTES, stream, a);
#endif
    const hipError_t le = hipPeekAtLastError();
    if (le != hipSuccess) fprintf(stderr, "kernel_launch: launch failed: %s\n", hipGetErrorName(le));
}
```

```cpp
#include <hip/hip_runtime.h>
#include <cstdio>
#include <cstdint>
namespace pg8 {
#define PG8_LAS __attribute__((address_space(3)))
typedef unsigned short bf16_t;
typedef short bf16x8 __attribute__((ext_vector_type(8)));
typedef float f32x4 __attribute__((ext_vector_type(4)));
typedef unsigned u32x4 __attribute__((ext_vector_type(4)));
constexpr int BM = 256, BK = 64, HALF = 128, HTB = HALF * BK * 2  , STAGE_BYTES = 8 * HTB, NXCD = 8, WGM = 8;

__host__ __device__ __forceinline__ int lds_byte(int r, int c) { const int st = (r >> 4) * 2 + (c >> 5), rr = r & 15, cc = c & 31, ob = rr * 64 + cc * 2; return st * 1024 + (ob ^ (((ob >> 9) & 1) << 5)); }
__host__ __device__ __forceinline__ void stage_rc(int b, int& R, int& C) { const int st = b / 1024, sb = b % 1024, swz = sb ^ (((sb >> 9) & 1) << 5); R = (st >> 1) * 16 + swz / 64; C = (st & 1) * 32 + (swz % 64) / 2; }
__host__ __device__ __forceinline__ int perm32(int rho) { const int n = rho >> 4, i = rho & 15; return 8 * (i >> 2) + 4 * n + (i & 3); }

struct Unit { int pm, pn; };
struct Gemm { const bf16_t* A; const bf16_t* Bt; int M, N, K; };

struct StaticOrder {
    int nM, nN, nwg, G, c;
    __host__ __device__ void init(int M, int N, int G_, int c_) { nM = M / BM; nN = N / BM; nwg = nM * nN; G = G_; c = c_; }
    __host__ __device__ bool next(int i, Unit& u) const {
        const long L = (long)i * G + c; if (L >= nwg) return false;
        int wgid = (int)L; { const int q = nwg / NXCD, r = nwg % NXCD, xcd = wgid % NXCD, off = wgid / NXCD; wgid = (xcd < r ? xcd * (q + 1) : r * (q + 1) + (xcd - r) * q) + off; }
        const int nig = WGM * nN, gid = wgid / nig, fm = gid * WGM, gsz = (nM - fm) < WGM ? (nM - fm) : WGM;
        u.pm = fm + ((wgid % nig) % gsz); u.pn = (wgid % nig) / gsz; return true;
    }
    __device__ __forceinline__ void a_ready(const Unit&) const {}
    __device__ __forceinline__ void done(const Unit&) const {}
};

__device__ __forceinline__ unsigned cvt_pk_bf16(float lo, float hi) { unsigned r; asm volatile("v_cvt_pk_bf16_f32 %0, %1, %2" : "=v"(r) : "v"(lo), "v"(hi)); return r; }
typedef float f32x2 __attribute__((ext_vector_type(2)));

template <class F> struct EpiGen {
    static constexpr bool PERM = true, AFTER_DRAIN = false;
    F f;
    __device__ __forceinline__ void operator()(const f32x4 (&acc)[2][2][4][2], const Unit& u, int wr, int wc, int fr, int fq) const {
        const int row0 = u.pm * BM + wr * 64 + fr, col0 = u.pn * BM + wc * 32 + 8 * fq;
#pragma unroll
        for (int ai = 0; ai < 2; ++ai)
#pragma unroll
            for (int m = 0; m < 4; ++m)
#pragma unroll
                for (int bj = 0; bj < 2; ++bj)
                    f.store8(row0 + ai * HALF + m * 16, col0 + bj * HALF, u.pn, acc[ai][bj][m][0], acc[ai][bj][m][1]);
    }
};
template <class Epi, class Sched, bool ALIGN_EPI = false, bool SP2 = false>
__device__ __forceinline__ void gemm_phase(PG8_LAS unsigned char* lds, const Gemm g, const Sched& S, const Epi& E) {
    const int tid = threadIdx.x, wid = __builtin_amdgcn_readfirstlane(tid >> 6), lane = tid & 63, wr = wid >> 2, wc = wid & 3, fr = lane & 15, fq = lane >> 4;
    const int K = g.K, nt = K / BK;
    unsigned voffA[2], voffB[2];
#pragma unroll
    for (int i = 0; i < 2; ++i) { int R, C; stage_rc(tid * 16 + i * 8192, R, C); const int Rb = Epi::PERM ? ((R & ~31) + perm32(R & 31)) : R;
        voffA[i] = (unsigned)(R * K + C) * 2u; voffB[i] = (unsigned)(Rb * K + C) * 2u; }
    const size_t kstep = (size_t)(BK * 2);
    const size_t hstep = (size_t)HALF * K * 2;
    const size_t tstep = 2 * hstep;
    const unsigned ldsw = (unsigned)wid * 1024u;
    const int aoff = lds_byte(wr * 64 + fr, fq * 8), boff = lds_byte(wc * 32 + fr, fq * 8);
#define PG8_SA(b, h) (((b) * 2 + (h)) * HTB)
#define PG8_SB(b, h) ((4 + (b) * 2 + (h)) * HTB)
#define PG8_STAGE(bufoff, gbase, voff) do { _Pragma("unroll") for (int _i = 0; _i < 2; ++_i) \
        __builtin_amdgcn_global_load_lds((const unsigned*)((const char*)(gbase) + (voff)[_i]), (PG8_LAS unsigned*)(lds + (bufoff) + ldsw + _i * 8192), 16, 0, 0); } while (0)
#define PG8_LDA(dst, b, h) do { _Pragma("unroll") for (int m = 0; m < 4; ++m) _Pragma("unroll") for (int k = 0; k < 2; ++k) dst[m][k] = *(const PG8_LAS bf16x8*)(lds + PG8_SA(b, h) + aoff + m * 2048 + k * 1024); } while (0)
#define PG8_LDB(dst, b, h) do { _Pragma("unroll") for (int n = 0; n < 2; ++n) _Pragma("unroll") for (int k = 0; k < 2; ++k) dst[n][k] = *(const PG8_LAS bf16x8*)(lds + PG8_SB(b, h) + boff + n * 2048 + k * 1024); } while (0)
#define PG8_MMA(ai, bj, At, Bt) do { __builtin_amdgcn_s_setprio(1); _Pragma("unroll") for (int m = 0; m < 4; ++m) _Pragma("unroll") for (int n = 0; n < 2; ++n) _Pragma("unroll") for (int k = 0; k < 2; ++k) \
        acc[ai][bj][m][n] = __builtin_amdgcn_mfma_f32_16x16x32_bf16(Bt[n][k], At[m][k], acc[ai][bj][m][n], 0, 0, 0); __builtin_amdgcn_s_setprio(0); } while (0)
#define PG8_WAIT_V(n) asm volatile("s_waitcnt vmcnt(" #n ")" ::: "memory")
#define PG8_WAIT_L(n) asm volatile("s_waitcnt lgkmcnt(" #n ")" ::: "memory")
#define PG8_BAR __builtin_amdgcn_s_barrier()
#define PG8_SCHED __builtin_amdgcn_sched_barrier(0)
    Unit cur, nxt; int ui = 0;
    if (!S.next(0, cur)) return;
    f32x4 acc[2][2][4][2];
#pragma unroll
    for (int a = 0; a < 2; ++a)
#pragma unroll
        for (int b = 0; b < 2; ++b)
#pragma unroll
            for (int m = 0; m < 4; ++m)
#pragma unroll
                for (int n = 0; n < 2; ++n) acc[a][b][m][n] = (f32x4){0.f, 0.f, 0.f, 0.f};
    bf16x8 At[4][2], B0[2][2], B1[2][2];
    const char* cA = (const char*)g.A + (size_t)cur.pm * tstep; const char* cB = (const char*)g.Bt + (size_t)cur.pn * tstep;
    S.a_ready(cur);
    if constexpr (SP2) {
        PG8_STAGE(PG8_SB(0, 0), cB, voffB); PG8_STAGE(PG8_SB(0, 1), cB + hstep, voffB); PG8_STAGE(PG8_SA(0, 0), cA, voffA); PG8_STAGE(PG8_SA(0, 1), cA + hstep, voffA);
        if (wr == 1) PG8_BAR;
        PG8_WAIT_V(2); PG8_BAR;
        PG8_STAGE(PG8_SB(1, 0), cB + kstep, voffB); PG8_STAGE(PG8_SA(1, 0), cA + kstep, voffA); PG8_STAGE(PG8_SB(1, 1), cB + hstep + kstep, voffB);
        PG8_WAIT_V(6); PG8_BAR;
    } else {
        PG8_STAGE(PG8_SB(0, 0), cB, voffB); PG8_STAGE(PG8_SA(0, 0), cA, voffA); PG8_STAGE(PG8_SB(0, 1), cB + hstep, voffB); PG8_STAGE(PG8_SA(0, 1), cA + hstep, voffA);
        if (wr == 1) PG8_BAR;
        PG8_WAIT_V(4); PG8_BAR;
        PG8_STAGE(PG8_SB(1, 0), cB + kstep, voffB); PG8_STAGE(PG8_SA(1, 0), cA + kstep, voffA); PG8_STAGE(PG8_SB(1, 1), cB + hstep + kstep, voffB);
        PG8_WAIT_V(6); PG8_BAR;
    }
    for (;;) {
        const bool has_next = S.next(ui + 1, nxt);
        const char* nA = has_next ? (const char*)g.A + (size_t)nxt.pm * tstep : cA; const char* nB = has_next ? (const char*)g.Bt + (size_t)nxt.pn * tstep : cB;
        for (int t = 0; t < nt; t += 2) {
            const bool last = (t == nt - 2);
            const char* a1 = cA + (size_t)(t + 1) * kstep;
            const char* a2 = last ? nA : cA + (size_t)(t + 2) * kstep; const char* b2 = last ? nB : cB + (size_t)(t + 2) * kstep;
            const char* a3 = a2 + kstep; const char* b3 = b2 + kstep;
            if (last && has_next) S.a_ready(nxt);
            if constexpr (SP2) {
            PG8_LDB(B0, 0, 0); PG8_LDB(B1, 0, 1); PG8_SCHED; PG8_LDA(At, 0, 0); PG8_STAGE(PG8_SA(1, 1), a1 + hstep, voffA);
            PG8_WAIT_V(8); PG8_WAIT_L(0); PG8_BAR; PG8_MMA(0, 0, At, B0); PG8_MMA(0, 1, At, B1); PG8_BAR; PG8_SCHED;
            PG8_LDA(At, 0, 1); PG8_STAGE(PG8_SB(0, 0), b2, voffB); PG8_STAGE(PG8_SB(0, 1), b2 + hstep, voffB); PG8_STAGE(PG8_SA(0, 0), a2, voffA);
            PG8_WAIT_V(8); PG8_WAIT_L(0); PG8_BAR; PG8_MMA(1, 0, At, B0); PG8_MMA(1, 1, At, B1); PG8_BAR; PG8_SCHED;
            PG8_LDB(B0, 1, 0); PG8_LDB(B1, 1, 1); PG8_SCHED; PG8_LDA(At, 1, 0); PG8_STAGE(PG8_SA(0, 1), a2 + hstep, voffA);
            PG8_WAIT_V(8); PG8_WAIT_L(0); PG8_BAR; PG8_MMA(0, 0, At, B0); PG8_MMA(0, 1, At, B1); PG8_BAR; PG8_SCHED;
            PG8_LDA(At, 1, 1); PG8_STAGE(PG8_SB(1, 0), b3, voffB); PG8_STAGE(PG8_SB(1, 1), b3 + hstep, voffB); PG8_STAGE(PG8_SA(1, 0), a3, voffA);
            PG8_WAIT_V(8); PG8_WAIT_L(0); PG8_BAR; PG8_MMA(1, 0, At, B0); PG8_MMA(1, 1, At, B1); PG8_BAR; PG8_SCHED;
            } else {
            PG8_LDB(B0, 0, 0); PG8_SCHED; PG8_LDA(At, 0, 0); PG8_STAGE(PG8_SA(1, 1), a1 + hstep, voffA);
            PG8_WAIT_L(8); PG8_BAR; PG8_WAIT_L(0); PG8_MMA(0, 0, At, B0); PG8_BAR; PG8_SCHED;
            PG8_LDB(B1, 0, 1); PG8_STAGE(PG8_SB(0, 0), b2, voffB);
            PG8_BAR; PG8_WAIT_L(0); PG8_MMA(0, 1, At, B1); PG8_BAR;
            PG8_LDA(At, 0, 1); PG8_STAGE(PG8_SA(0, 0), a2, voffA);
            PG8_BAR; PG8_WAIT_L(0); PG8_MMA(1, 0, At, B0); PG8_BAR; PG8_SCHED;
            PG8_STAGE(PG8_SB(0, 1), b2 + hstep, voffB);
            PG8_WAIT_V(6); PG8_BAR; PG8_MMA(1, 1, At, B1); PG8_BAR;
            PG8_LDB(B0, 1, 0); PG8_SCHED; PG8_LDA(At, 1, 0); PG8_STAGE(PG8_SA(0, 1), a2 + hstep, voffA);
            PG8_WAIT_L(8); PG8_BAR; PG8_WAIT_L(0); PG8_MMA(0, 0, At, B0); PG8_BAR; PG8_SCHED;
            PG8_LDB(B1, 1, 1); PG8_STAGE(PG8_SB(1, 0), b3, voffB);
            PG8_BAR; PG8_WAIT_L(0); PG8_MMA(0, 1, At, B1); PG8_BAR;
            PG8_LDA(At, 1, 1); PG8_STAGE(PG8_SA(1, 0), a3, voffA);
            PG8_BAR; PG8_WAIT_L(0); PG8_MMA(1, 0, At, B0); PG8_BAR; PG8_SCHED;
            PG8_STAGE(PG8_SB(1, 1), b3 + hstep, voffB);
            PG8_WAIT_V(6); PG8_BAR; PG8_MMA(1, 1, At, B1); PG8_BAR;
            }
        }
        if constexpr (ALIGN_EPI) { if (wr == 0) PG8_BAR; }
        if constexpr (!Epi::AFTER_DRAIN) { E(acc, cur, wr, wc, fr, fq); S.done(cur); }
        if (!has_next) break;
#pragma unroll
        for (int a = 0; a < 2; ++a)
#pragma unroll
            for (int b = 0; b < 2; ++b)
#pragma unroll
                for (int m = 0; m < 4; ++m)
#pragma unroll
                    for (int n = 0; n < 2; ++n) acc[a][b][m][n] = (f32x4){0.f, 0.f, 0.f, 0.f};
        cur = nxt; cA = nA; cB = nB; ++ui;
        if constexpr (ALIGN_EPI) { if (wr == 1) PG8_BAR; }
    }
    PG8_WAIT_V(0);
    if constexpr (!ALIGN_EPI) { if (wr == 0) PG8_BAR; }
    PG8_BAR;
    if constexpr (Epi::AFTER_DRAIN) { E.fused(acc, cur, wr, wc, fr, fq, lds, wid, lane); S.done(cur); }
#undef PG8_SA
#undef PG8_SB
#undef PG8_STAGE
#undef PG8_LDA
#undef PG8_LDB
#undef PG8_MMA
#undef PG8_WAIT_V
#undef PG8_WAIT_L
#undef PG8_BAR
#undef PG8_SCHED
}
}
#define GAS __attribute__((address_space(1)))
#define LAS __attribute__((address_space(3)))
typedef unsigned short bf16;
typedef unsigned v4u __attribute__((ext_vector_type(4)));
typedef float f32x4 __attribute__((ext_vector_type(4)));
typedef short bf16x8 __attribute__((ext_vector_type(8)));
typedef GAS unsigned gu32;
typedef GAS unsigned long long gu64;
#define RLX_AGENT __ATOMIC_RELAXED, __HIP_MEMORY_SCOPE_AGENT
#define LDS_WAIT() asm volatile("s_waitcnt lgkmcnt(0)" ::: "memory")
#define VM_WAIT() asm volatile("s_waitcnt vmcnt(0)" ::: "memory")
__device__ __forceinline__ unsigned long long rt() { return __builtin_amdgcn_s_memrealtime(); }
__device__ __forceinline__ unsigned f2bf(float f) { unsigned u = __builtin_bit_cast(unsigned, f); return (u + 0x7fffu + ((u >> 16) & 1u)) >> 16; }
__device__ __forceinline__ unsigned pk2(float lo, float hi) { return f2bf(lo) | (f2bf(hi) << 16); }

#define XB_TMO      128
#define XB_XCNT(j)  (256  + 64 * (j))
#define XB_XSUB(j)  (1280 + 64 * (j))
#define XB_XGEN(j)  (2304 + 64 * (j))
#define XB_TOP      3328
#define XB_TOPGEN   3392
#define XCD_BAR_WORDS 3456
#define XB_SPIN_CAP (1u << 18)

__device__ __forceinline__ unsigned xb_ld(unsigned* p)              { return __hip_atomic_load(p, __ATOMIC_RELAXED, __HIP_MEMORY_SCOPE_AGENT); }
__device__ __forceinline__ unsigned xb_add(unsigned* p, unsigned v) { return __hip_atomic_fetch_add(p, v, __ATOMIC_RELAXED, __HIP_MEMORY_SCOPE_AGENT); }
__device__ __forceinline__ unsigned xb_xcc_id() { return (unsigned)__builtin_amdgcn_s_getreg((3 << 11) | 20) & 0xFu; }
#define XB_SPIN(cond, bar) do { unsigned _sp = 0; while (cond) { __builtin_amdgcn_s_sleep(1); \
    if ((++_sp & 255u) == 0u) { if (xb_ld(&(bar)[XB_TMO])) break; if (_sp > XB_SPIN_CAP) { atomicAdd(&(bar)[XB_TMO], 1u); break; } } } } while (0)

struct XcdBarrier {
    unsigned* bar; unsigned x;
    volatile LAS unsigned* st;
};

__device__ __forceinline__ XcdBarrier xcd_barrier_post(unsigned* bar, volatile LAS unsigned* st) {
    XcdBarrier b; b.bar = bar; b.x = xb_xcc_id(); b.st = st;
    if (threadIdx.x == 0) (void)xb_add(&bar[XB_XCNT(b.x)], 1u);
    return b;
}
__device__ __forceinline__ void xcd_barrier_complete(unsigned* bar, unsigned x, unsigned& nloc, unsigned& nx) {
    const unsigned G = gridDim.x * gridDim.y * gridDim.z;
    unsigned sum, cnt, mine, sp = 0u;
    for (;;) {
        sum = 0u; cnt = 0u; mine = 0u;
#pragma unroll
        for (unsigned j = 0; j < 16; ++j) { const unsigned c = xb_ld(&bar[XB_XCNT(j)]); sum += c; cnt += (c > 0u) ? 1u : 0u; mine = (j == x) ? c : mine; }
        if (sum == G) break;
        __builtin_amdgcn_s_sleep(1);
        if ((++sp & 255u) == 0u) { if (xb_ld(&bar[XB_TMO])) break; if (sp > XB_SPIN_CAP) { atomicAdd(&bar[XB_TMO], 1u); break; } }
    }
    nloc = mine > 0u ? mine : 1u; nx = cnt > 0u ? cnt : 1u;
}

__device__ __forceinline__ void xcd_barrier(const XcdBarrier& b) {
    asm volatile("s_waitcnt vmcnt(0)" ::: "memory");
    __syncthreads();
    if (threadIdx.x == 0) {
        unsigned* bar = b.bar;
        __builtin_amdgcn_s_waitcnt(0);
        unsigned nloc = b.st[0], nx = b.st[1];
        if (nloc == 0u) { xcd_barrier_complete(bar, b.x, nloc, nx); b.st[0] = nloc; b.st[1] = nx; }
        const unsigned old = xb_add(&bar[XB_XSUB(b.x)], 1u);
        const unsigned gen = old / nloc;
        if (old + 1u == (gen + 1u) * nloc) {
            __builtin_amdgcn_fence(__ATOMIC_RELEASE, "agent");
            asm volatile("s_waitcnt vmcnt(0)" ::: "memory");
            const unsigned og = xb_add(&bar[XB_TOP], 1u);
            const unsigned tg = og / nx;
            if (og + 1u == (tg + 1u) * nx) xb_add(&bar[XB_TOPGEN], 1u);
            else XB_SPIN(xb_ld(&bar[XB_TOPGEN]) == tg, bar);
            __builtin_amdgcn_fence(__ATOMIC_ACQUIRE, "agent");
            xb_add(&bar[XB_XGEN(b.x)], 1u);
            asm volatile("s_waitcnt vmcnt(0)" ::: "memory");
        } else {
            XB_SPIN(xb_ld(&bar[XB_XGEN(b.x)]) == gen, bar);
            __builtin_amdgcn_fence(__ATOMIC_ACQUIRE, "agent");
            asm volatile("s_waitcnt vmcnt(0)" ::: "memory");
        }
    }
    __syncthreads();
}

constexpr int NWAVES = 8, NTHR = 512;
constexpr int DM = 1024, SEQ = 8192, NB = 2, MP = NB * SEQ;
constexpr int DB = 32, DS = 8, MS = DB * DS, MT = MP + MS;
constexpr int AH = 8, AD = 64, AW = 512;
constexpr int BH = 4, BK_ = 128, BV = 256, BKW = 512, BVW = 1024, GR = 16;
constexpr int DFF = 2816, DFF2 = 5632;
constexpr int PAST = 8192, PAGE = 128, NPAGES = 64;
constexpr int DIN = 6680, NU = 6912;
constexpr int UC_QA = 0, UC_KA = 512, UC_VA = 1024, UC_QB = 1536, UC_KB = 2048, UC_VB = 2560, UC_RB = 3584, UC_GA = 4608, UC_GB = 5632, UC_FA = 6656, UC_AL = 6664;
constexpr float EPS = 1e-6f;
constexpr float LOG2E = 1.4426950408889634f;
constexpr float C2 = 0.125f * LOG2E;
constexpr float QB_SCALE = 0.08838834764831845f;
constexpr size_t OFF_YP = 0, OFF_YS = (size_t)MP * DM, OFF_KP = OFF_YS + (size_t)MS * DM, OFF_VP = OFF_KP + (size_t)MP * AW, OFF_FP = OFF_VP + (size_t)MP * AW,
                 OFF_GP = OFF_FP + (size_t)MP * AH, OFF_CP = OFF_GP + (size_t)NB * BH * BK_ * BV, OFF_KS = OFF_CP + (size_t)NB * 2 * DFF2, OFF_VS = OFF_KS + (size_t)MS * AW,
                 OFF_FS = OFF_VS + (size_t)MS * AW, OFF_GS = OFF_FS + (size_t)MS * AH, OFF_CS = OFF_GS + (size_t)DB * BH * BK_ * BV, OUT_TOTAL = OFF_CS + (size_t)DB * 2 * DFF2;
static_assert(OUT_TOTAL == 39051264, "output size");

constexpr size_t MiB = 1u << 20;
constexpr size_t WS_CTL = 0, CTL_ZERO_BYTES = 1 * MiB;
constexpr size_t al_(size_t x) { return (x + (MiB - 1)) & ~(MiB - 1); }
constexpr size_t WS_WIN = al_(WS_CTL + CTL_ZERO_BYTES);
constexpr size_t WS_WPA = al_(WS_WIN + (size_t)NU * DM * 2);
constexpr size_t WS_WPB = al_(WS_WPA + (size_t)DM * AW * 2);
constexpr size_t WS_WOUT = al_(WS_WPB + (size_t)DM * BVW * 2);
constexpr size_t WS_WUP = al_(WS_WOUT + (size_t)DM * DM * 2);
constexpr size_t WS_WDN = al_(WS_WUP + (size_t)DFF2 * DM * 2);
constexpr size_t WS_ALOW = al_(WS_WDN + (size_t)DM * DFF * 2);
constexpr size_t WS_FA = al_(WS_ALOW + (size_t)MT * GR * 4);
constexpr size_t WS_CB = al_(WS_FA + (size_t)MT * AH * 4);
constexpr size_t WS_SB = al_(WS_CB + (size_t)NB * AH * SEQ * 4);
constexpr size_t WS_PART = al_(WS_SB + (size_t)DB * AH * PAST * 4);
constexpr size_t WS_XN = al_(WS_PART + (size_t)256 * AH * DS * 68 * 4);
constexpr size_t WS_OA = al_(WS_XN + (size_t)MT * DM * 2);
constexpr size_t WS_OB = al_(WS_OA + (size_t)MT * AW * 2);
constexpr size_t WS_MG = al_(WS_OB + (size_t)MT * BVW * 2);
constexpr size_t WS_XN2 = al_(WS_MG + (size_t)MT * DM * 2);
constexpr size_t WS_ACT = al_(WS_XN2 + (size_t)MT * DM * 2);
constexpr size_t WS_U = al_(WS_ACT + (size_t)MT * DFF * 2);
constexpr size_t WS_UU = al_(WS_U + (size_t)MT * NU * 2);
constexpr size_t WS_OBR = al_(WS_UU + (size_t)MT * DFF2 * 2);
constexpr size_t WS_TA = al_(WS_OBR + (size_t)MT * BVW * 4);
constexpr size_t WS_F1 = al_(WS_TA + (size_t)MT * DM * 4);
constexpr size_t WS_X1 = al_(WS_F1 + (size_t)MT * DM * 4);
constexpr size_t WS_F2 = al_(WS_X1 + (size_t)MT * DM * 4);
constexpr size_t WS_LS = al_(WS_F2 + (size_t)MT * DM * 4);
constexpr size_t WS_DSC = al_(WS_LS + (size_t)256 * BK_ * BV * 4);
constexpr size_t WS_END = al_(WS_DSC + (size_t)256 * BK_ * 4);
static_assert(WS_END < (size_t)2600 * MiB, "workspace");
constexpr int CW_BAR = 4096;
constexpr int PART_STRIDE = 68;

constexpr int RING_OFF = 0, RING_BYTES = 147456;
constexpr int LDSCTL_OFF = RING_BYTES, MISC_OFF = LDSCTL_OFF + 320;
constexpr int LDS_BYTES = 151552;

typedef unsigned short bf16;
typedef unsigned v4u __attribute__((ext_vector_type(4)));
typedef unsigned v2u __attribute__((ext_vector_type(2)));
typedef float f32x4 __attribute__((ext_vector_type(4)));
typedef float f32x16 __attribute__((ext_vector_type(16)));
typedef short bf16x8 __attribute__((ext_vector_type(8)));
typedef short s16x4 __attribute__((ext_vector_type(4)));

__device__ __forceinline__ float bf2f(unsigned short u) { return __uint_as_float((unsigned)u << 16); }
__device__ __forceinline__ float bflo(unsigned u) { return __uint_as_float(u << 16); }
__device__ __forceinline__ float bfhi(unsigned u) { return __uint_as_float(u & 0xffff0000u); }
__device__ __forceinline__ float sigmoidf_(float x) { return 1.f / (1.f + __expf(-x)); }
__device__ __forceinline__ float logsigmoidf_(float x) { return fminf(x, 0.f) - log1pf(expf(-fabsf(x))); }
__device__ __forceinline__ float wave_sum(float v) {
#pragma unroll
    for (int o = 1; o < 64; o <<= 1) v += __shfl_xor(v, o);
    return v;
}

struct Ctx {
    LAS unsigned char* lds;
    int tid, lane, wave, G, bid;
    const float* in[24];
    float* out; unsigned char* ws;
};
#define INF(k) ((const float*)C.in[k])
enum { I_XP = 0, I_XS, I_CK, I_CV, I_CF, I_SG, I_SC, I_PT, I_GPM, I_WIN, I_BF, I_WA2, I_BA, I_GGLA, I_WPA, I_WPB, I_WOUT, I_GPOM, I_GPF, I_WUP, I_WCONV, I_BCONV, I_WDN, I_GPOF };

__device__ __forceinline__ void transpose_item(const float* W, int ldw, int c0, int ncols, int K, bf16* WT, int r0, LAS float* scr, int item, int lane) {
    const int nblk = (ncols + 31) / 32, kb = item / nblk, nb = item % nblk, k0 = 64 * kb, n0 = 32 * nb;
    const bool cok = (n0 + (lane & 31)) < ncols;
#pragma unroll 8
    for (int i = 0; i < 32; ++i) { const int kk = 2 * i + (lane >> 5); scr[kk * 33 + (lane & 31)] = cok ? W[(size_t)(k0 + kk) * ldw + c0 + n0 + (lane & 31)] : 0.f; }
    LDS_WAIT(); asm volatile("" ::: "memory");
    const int c = lane & 7;
#pragma unroll
    for (int j = 0; j < 4; ++j) { const int n = (lane >> 3) + 8 * j; const LAS float* s = scr + (8 * c) * 33 + n;
        v4u o; o.x = pk2(s[0 * 33], s[1 * 33]); o.y = pk2(s[2 * 33], s[3 * 33]); o.z = pk2(s[4 * 33], s[5 * 33]); o.w = pk2(s[6 * 33], s[7 * 33]);
        if (n0 + n < ncols) *(GAS v4u*)(WT + (size_t)(r0 + n0 + n) * K + k0 + 8 * c) = o; }
    LDS_WAIT(); asm volatile("" ::: "memory");
}
__device__ __forceinline__ void rms_row_to_bf16(const float* xrow, const float* g, bf16* orow, int lane) {
    const GAS f32x4* xr = (const GAS f32x4*)xrow + lane; const GAS f32x4* gr = (const GAS f32x4*)g + lane;
    f32x4 v[4]; float s = 0.f;
#pragma unroll
    for (int j = 0; j < 4; ++j) { v[j] = xr[64 * j]; s += (v[j].x * v[j].x + v[j].y * v[j].y) + (v[j].z * v[j].z + v[j].w * v[j].w); }
    const float r = 1.f / sqrtf(wave_sum(s) * (1.f / DM) + EPS);
    GAS unsigned long long* o8 = (GAS unsigned long long*)orow + lane;
#pragma unroll
    for (int j = 0; j < 4; ++j) { const f32x4 gg = gr[64 * j]; o8[64 * j] = (unsigned long long)pk2(v[j].x * r * gg.x, v[j].y * r * gg.y) | ((unsigned long long)pk2(v[j].z * r * gg.z, v[j].w * r * gg.w) << 32); }
}
__device__ __forceinline__ void p0_prologue(Ctx& C) {
    LAS float* scr = (LAS float*)(C.lds + RING_OFF + C.wave * 16384);
    const int gw = C.bid * NWAVES + C.wave, NGW = C.G * NWAVES;
    bf16* Win = (bf16*)(C.ws + WS_WIN);
#define SEG(c0, w, r0) { const int ni = (((w) + 31) / 32) * (DM / 64); for (int it = gw; it < ni; it += NGW) transpose_item(INF(I_WIN), DIN, (c0), (w), DM, Win, (r0), scr, it, C.lane); }
    SEG(0, 512, UC_QA) SEG(512, 512, UC_KA) SEG(1024, 512, UC_VA) SEG(1536, 8, UC_FA) SEG(1544, 512, UC_QB) SEG(2056, 512, UC_KB)
    SEG(2568, 1024, UC_VB) SEG(3592, 16, UC_AL) SEG(3608, 1024, UC_RB) SEG(4632, 1024, UC_GA) SEG(5656, 1024, UC_GB)
#undef SEG
    { const int ni = (DM / 32) * (AW / 64); for (int it = gw; it < ni; it += NGW) transpose_item(INF(I_WPA), DM, 0, DM, AW, (bf16*)(C.ws + WS_WPA), 0, scr, it, C.lane); }
    { const int ni = (DM / 32) * (BVW / 64); for (int it = gw; it < ni; it += NGW) transpose_item(INF(I_WPB), DM, 0, DM, BVW, (bf16*)(C.ws + WS_WPB), 0, scr, it, C.lane); }
    { const int ni = (DM / 32) * (DM / 64); for (int it = gw; it < ni; it += NGW) transpose_item(INF(I_WOUT), DM, 0, DM, DM, (bf16*)(C.ws + WS_WOUT), 0, scr, it, C.lane); }
    { const int ni = (DFF2 / 32) * (DM / 64); for (int it = gw; it < ni; it += NGW) transpose_item(INF(I_WUP), DFF2, 0, DFF2, DM, (bf16*)(C.ws + WS_WUP), 0, scr, it, C.lane); }
    { const int ni = (DM / 32) * (DFF / 64); for (int it = gw; it < ni; it += NGW) transpose_item(INF(I_WDN), DM, 0, DM, DFF, (bf16*)(C.ws + WS_WDN), 0, scr, it, C.lane); }
    { const int n16 = (NU - DIN) * DM * 2 / 16; GAS v4u* z = (GAS v4u*)(Win + (size_t)DIN * DM);
      for (int i = C.bid * NTHR + C.tid; i < n16; i += C.G * NTHR) z[i] = (v4u){0u, 0u, 0u, 0u}; }
    bf16* XN = (bf16*)(C.ws + WS_XN);
    for (int m = gw; m < MT; m += NGW) { const float* xr = m < MP ? INF(I_XP) + (size_t)m * DM : INF(I_XS) + (size_t)(m - MP) * DM; rms_row_to_bf16(xr, INF(I_GPM), XN + (size_t)m * DM, C.lane); }
}

__device__ __forceinline__ v4u pack8(f32x4 a, f32x4 b, float s) { v4u w; w.x = pg8::cvt_pk_bf16(a[0] * s, a[1] * s); w.y = pg8::cvt_pk_bf16(a[2] * s, a[3] * s); w.z = pg8::cvt_pk_bf16(b[0] * s, b[1] * s); w.w = pg8::cvt_pk_bf16(b[2] * s, b[3] * s); return w; }
struct StInProj {
    bf16* U; float* out; float* alow; float* fa;
    __device__ __forceinline__ void store8(int row, int col, int pn, f32x4 a, f32x4 b) const {
        if (pn == 26) {
            if (col == UC_FA) {
                float* dst = fa + (size_t)row * AH;
                *(f32x4*)dst = a; *(f32x4*)(dst + 4) = b;
            } else if (col == UC_AL || col == UC_AL + 8) {
                float* dst = alow + (size_t)row * GR + (col - UC_AL);
                *(f32x4*)dst = a; *(f32x4*)(dst + 4) = b;
            }
            return;
        }
        const float sc = pn < 2 ? C2 : ((pn == 6 || pn == 7) ? QB_SCALE : 1.f);
        *(v4u*)(U + (size_t)row * NU + col) = pack8(a, b, sc);
        if (pn >= 2 && pn < 6) {
            float* dst;
            if (pn < 4) dst = (row < MP ? out + OFF_KP + (size_t)row * AW : out + OFF_KS + (size_t)(row - MP) * AW) + (col - UC_KA);
            else        dst = (row < MP ? out + OFF_VP + (size_t)row * AW : out + OFF_VS + (size_t)(row - MP) * AW) + (col - UC_VA);
            *(f32x4*)dst = a; *(f32x4*)(dst + 4) = b;
        }
    }
};
struct StProjA {
    const bf16* U; float* TA;
    __device__ __forceinline__ void store8(int row, int col, int, f32x4 a, f32x4 b) const {
        const v4u g = *(const v4u*)(U + (size_t)row * NU + UC_GA + col);
        f32x4 x, y;
        x[0] = a[0] * sigmoidf_(bflo(g.x)); x[1] = a[1] * sigmoidf_(bfhi(g.x)); x[2] = a[2] * sigmoidf_(bflo(g.y)); x[3] = a[3] * sigmoidf_(bfhi(g.y));
        y[0] = b[0] * sigmoidf_(bflo(g.z)); y[1] = b[1] * sigmoidf_(bfhi(g.z)); y[2] = b[2] * sigmoidf_(bflo(g.w)); y[3] = b[3] * sigmoidf_(bfhi(g.w));
        float* dst = TA + (size_t)row * DM + col; *(f32x4*)dst = x; *(f32x4*)(dst + 4) = y;
    }
};
struct StProjB {
    const bf16* U; const float* TA; bf16* MG;
    __device__ __forceinline__ void store8(int row, int col, int, f32x4 a, f32x4 b) const {
        const v4u g = *(const v4u*)(U + (size_t)row * NU + UC_GB + col);
        const float* src = TA + (size_t)row * DM + col; const f32x4 t0 = *(const f32x4*)src, t1 = *(const f32x4*)(src + 4);
        f32x4 x, y;
        x[0] = t0[0] + a[0] * sigmoidf_(bflo(g.x)); x[1] = t0[1] + a[1] * sigmoidf_(bfhi(g.x)); x[2] = t0[2] + a[2] * sigmoidf_(bflo(g.y)); x[3] = t0[3] + a[3] * sigmoidf_(bfhi(g.y));
        y[0] = t1[0] + b[0] * sigmoidf_(bflo(g.z)); y[1] = t1[1] + b[1] * sigmoidf_(bfhi(g.z)); y[2] = t1[2] + b[2] * sigmoidf_(bflo(g.w)); y[3] = t1[3] + b[3] * sigmoidf_(bfhi(g.w));
        *(v4u*)(MG + (size_t)row * DM + col) = pack8(x, y, 1.f);
    }
};
struct StF32 {
    float* O;
    __device__ __forceinline__ void store8(int row, int col, int, f32x4 a, f32x4 b) const { float* dst = O + (size_t)row * DM + col; *(f32x4*)dst = a; *(f32x4*)(dst + 4) = b; }
};
struct StUp {
    bf16* UU; float* out;
    __device__ __forceinline__ void store8(int row, int col, int, f32x4 a, f32x4 b) const {
        *(v4u*)(UU + (size_t)row * DFF2 + col) = pack8(a, b, 1.f);
        float* dst = nullptr;
        if (row < MP) { const int t = row & (SEQ - 1); if (t >= SEQ - 2) dst = out + OFF_CP + ((size_t)(row >> 13) * 2 + (t - (SEQ - 2))) * DFF2 + col; }
        else { const int r = row - MP, t = r & 7; if (t >= 6) dst = out + OFF_CS + ((size_t)(r >> 3) * 2 + (t - 6)) * DFF2 + col; }
        if (dst) { *(f32x4*)dst = a; *(f32x4*)(dst + 4) = b; }
    }
};

__device__ __forceinline__ void p2_scans(Ctx& C) {
    LAS float* red = (LAS float*)(C.lds + RING_OFF);
    const int* pt = (const int*)C.in[I_PT];
    const int nunits = NB * AH + DB * AH;
    for (int u = C.bid; u < nunits; u += C.G) {
        float v[16]; float tot = 0.f;
        if (u < NB * AH) {
            const int b = u >> 3, h = u & 7; const float* src = (const float*)(C.ws + WS_FA) + ((size_t)b * SEQ + C.tid * 16) * AH + h;
            float* lo_ = C.out + OFF_FP + ((size_t)b * SEQ + C.tid * 16) * AH + h; const float bfh = INF(I_BF)[h];
#pragma unroll
            for (int i = 0; i < 16; ++i) { const float lf = logsigmoidf_(src[(size_t)i * AH] + bfh); lo_[(size_t)i * AH] = lf; tot += lf; v[i] = tot; }
        } else {
            const int db = (u - NB * AH) >> 3, h = u & 7; const int p0 = C.tid * 16; const int pg = pt[db * NPAGES + (p0 >> 7)];
            const float* src = INF(I_CF) + ((size_t)pg * PAGE + (p0 & 127)) * AH + h;
#pragma unroll
            for (int i = 15; i >= 0; --i) { v[i] = tot; tot += src[(size_t)i * AH]; }
        }
        __syncthreads();
        red[C.tid] = tot;
        __syncthreads();
        float pre = 0.f;
        if (u < NB * AH) { for (int i = 0; i < C.tid; ++i) pre += red[i]; }
        else { for (int i = NTHR - 1; i > C.tid; --i) pre += red[i]; }
        float* dst = u < NB * AH ? (float*)(C.ws + WS_CB) + (size_t)u * SEQ + C.tid * 16 : (float*)(C.ws + WS_SB) + (size_t)(u - NB * AH) * PAST + C.tid * 16;
        const float sgn = u < NB * AH ? -LOG2E : LOG2E;
#pragma unroll
        for (int i = 0; i < 16; i += 4) *(f32x4*)(dst + i) = (f32x4){(v[i] + pre) * sgn, (v[i + 1] + pre) * sgn, (v[i + 2] + pre) * sgn, (v[i + 3] + pre) * sgn};
    }
    if (C.bid == C.G - 1) for (int e = C.tid; e < MS * AH; e += NTHR) C.out[OFF_FS + e] = logsigmoidf_(((const float*)(C.ws + WS_FA))[(size_t)MP * AH + e] + INF(I_BF)[e & 7]);
    __syncthreads();
}

namespace att {
constexpr int LDS_K = 0, LDS_V = 8192, LDS_WS = 16384, LDS_OST = LDS_WS + 8 * 64 * 4, LDS_TOTAL = LDS_OST + 8 * 4096;
__device__ __forceinline__ int crow(int r, int hi) { return (r & 3) + 8 * (r >> 2) + 4 * hi; }
__device__ __forceinline__ void glds16(const void* gsrc, unsigned lds_dst) { unsigned keep;
    asm volatile("s_mov_b32 %0, m0\n\ts_mov_b32 m0, %2\n\ts_nop 0\n\tglobal_load_lds_dwordx4 %1, off\n\ts_mov_b32 m0, %0" : "=&s"(keep) : "v"(gsrc), "s"(lds_dst) : "memory"); }
typedef float f32x2_t __attribute__((ext_vector_type(2))); typedef __bf16 bf16x2_t __attribute__((ext_vector_type(2)));
__device__ __forceinline__ unsigned cvtpk_s(float lo, float hi) { f32x2_t v = {lo, hi}; bf16x2_t b = __builtin_convertvector(v, bf16x2_t); return __builtin_bit_cast(unsigned, b); }
__device__ __forceinline__ void pv(f32x16* o, int vb, bf16x8 pa0, bf16x8 pa1, bf16x8 pa2, bf16x8 pa3) {
#pragma unroll
    for (int d0 = 0; d0 < 2; ++d0) { s16x4 lo[4], hi[4];
#pragma unroll
        for (int ks = 0; ks < 4; ++ks) {
            asm volatile("ds_read_b64_tr_b16 %0,%1 offset:%c2" : "=&v"(lo[ks]) : "v"(vb), "i"(d0 * 4096 + ks * 1024) : "memory");
            asm volatile("ds_read_b64_tr_b16 %0,%1 offset:%c2" : "=&v"(hi[ks]) : "v"(vb), "i"(d0 * 4096 + ks * 1024 + 512) : "memory"); }
        asm volatile("s_waitcnt lgkmcnt(0)" ::: "memory"); __builtin_amdgcn_sched_barrier(0);
#define PK(k) (bf16x8){lo[k][0], lo[k][1], lo[k][2], lo[k][3], hi[k][0], hi[k][1], hi[k][2], hi[k][3]}
        o[d0] = __builtin_amdgcn_mfma_f32_32x32x16_bf16(pa0, PK(0), o[d0], 0, 0, 0);
        o[d0] = __builtin_amdgcn_mfma_f32_32x32x16_bf16(pa1, PK(1), o[d0], 0, 0, 0);
        o[d0] = __builtin_amdgcn_mfma_f32_32x32x16_bf16(pa2, PK(2), o[d0], 0, 0, 0);
        o[d0] = __builtin_amdgcn_mfma_f32_32x32x16_bf16(pa3, PK(3), o[d0], 0, 0, 0);
#undef PK
    }
}
__device__ __forceinline__ void attn_unit(int b, int h, int qb, const bf16* U, const float* CB, bf16* OA, LAS unsigned char* shm) {
    const int tid = threadIdx.x, lane = tid & 63, r32 = lane & 31, hi = lane >> 5; const int wid = __builtin_amdgcn_readfirstlane(tid >> 6);
    const long rowbase = (long)b * SEQ; const int q0 = qb * 256;
    const bf16* Qw = U + (rowbase + q0 + wid * 32) * NU + UC_QA + h * 64;
    const bf16* Kh = U + rowbase * NU + UC_KA + h * 64; const bf16* Vh = U + rowbase * NU + UC_VA + h * 64;
    const float* CBh = CB + (size_t)(b * AH + h) * SEQ;
    const unsigned lds0 = (unsigned)(uintptr_t)shm;
    LAS float* wsf = (LAS float*)(shm + LDS_WS) + wid * 64;
    const bf16* ksrc = Kh + (long)lane * NU + wid * 8;
    const bf16* vsrc = Vh + (long)(16 * (wid & 3) + (lane >> 2)) * NU + (wid >> 2) * 32 + (lane & 3) * 8;
    const unsigned kdst = lds0 + LDS_K + wid * 1024, vdst = lds0 + LDS_V + wid * 1024;
    const int vb0 = (int)(lds0 + LDS_V) + ((lane >> 4) & 1) * 32 + (lane & 3) * 8 + (4 * hi + ((lane & 15) >> 2)) * 64;
    const LAS unsigned char* kp0 = shm + LDS_K + hi * 1024 + r32 * 16;
    const int NT = (q0 + 256) / 64;
    bf16x8 qr[4];
#pragma unroll
    for (int d0 = 0; d0 < 4; ++d0) qr[d0] = *(const bf16x8*)(Qw + (long)r32 * NU + d0 * 16 + hi * 8);
    float mrun = -INFINITY, lsum = 0.f; f32x16 o[2]; o[0] = f32x16{}; o[1] = f32x16{};
    const int qrel = wid * 32 + r32;
    for (int t = 0; t < NT; ++t) {
        glds16(ksrc + (long)t * 64 * NU, (unsigned)__builtin_amdgcn_readfirstlane(kdst));
        glds16(vsrc + (long)t * 64 * NU, (unsigned)__builtin_amdgcn_readfirstlane(vdst));
        f32x16 p0, p1;
#pragma unroll
        for (int g = 0; g < 4; ++g) { const f32x4 c0 = *(const f32x4*)(CBh + t * 64 + 8 * g + 4 * hi), c1 = *(const f32x4*)(CBh + t * 64 + 32 + 8 * g + 4 * hi);
            p0[4 * g] = c0[0]; p0[4 * g + 1] = c0[1]; p0[4 * g + 2] = c0[2]; p0[4 * g + 3] = c0[3]; p1[4 * g] = c1[0]; p1[4 * g + 1] = c1[1]; p1[4 * g + 2] = c1[2]; p1[4 * g + 3] = c1[3]; }
        asm volatile("s_waitcnt vmcnt(0) lgkmcnt(0)\n\ts_barrier" ::: "memory");
#pragma unroll
        for (int d0 = 0; d0 < 4; ++d0) {
            const bf16x8 k0 = *(const LAS bf16x8*)(kp0 + d0 * 2048), k1 = *(const LAS bf16x8*)(kp0 + d0 * 2048 + 512);
            p0 = __builtin_amdgcn_mfma_f32_32x32x16_bf16(k0, qr[d0], p0, 0, 0, 0);
            p1 = __builtin_amdgcn_mfma_f32_32x32x16_bf16(k1, qr[d0], p1, 0, 0, 0);
        }
        const int jb = t - (NT - 4);
        if (jb >= 0) { const int kb = 64 * jb + 4 * hi;
#pragma unroll
            for (int r = 0; r < 16; ++r) { const int kv = kb + (r & 3) + 8 * (r >> 2); if (kv > qrel) p0[r] = -INFINITY; if (kv + 32 > qrel) p1[r] = -INFINITY; } }
        float rm = p0[0];
#pragma unroll
        for (int r = 1; r < 16; ++r) rm = fmaxf(rm, p0[r]);
#pragma unroll
        for (int r = 0; r < 16; ++r) rm = fmaxf(rm, p1[r]);
        { auto rr = __builtin_amdgcn_permlane32_swap(__float_as_uint(rm), __float_as_uint(rm), false, false); rm = fmaxf(__uint_as_float(rr[0]), __uint_as_float(rr[1])); }
        const float mn = fmaxf(mrun, rm);
        const float f = __builtin_amdgcn_exp2f(mrun - mn); mrun = mn;
        float sacc = 0.f;
#pragma unroll
        for (int r = 0; r < 16; ++r) { p0[r] = __builtin_amdgcn_exp2f(p0[r] - mn); p1[r] = __builtin_amdgcn_exp2f(p1[r] - mn); sacc += p0[r] + p1[r]; }
        lsum = lsum * f + sacc;
        if (hi == 0) wsf[r32] = f;
        asm volatile("s_waitcnt lgkmcnt(0)" ::: "memory");
#pragma unroll
        for (int r = 0; r < 16; ++r) { const float fr = wsf[crow(r, hi)]; o[0][r] *= fr; o[1][r] *= fr; }
        v4u pw0, pw1, pw2, pw3;
        pw0 = (v4u){cvtpk_s(p0[0], p0[1]), cvtpk_s(p0[2], p0[3]), cvtpk_s(p0[4], p0[5]), cvtpk_s(p0[6], p0[7])};
        pw1 = (v4u){cvtpk_s(p0[8], p0[9]), cvtpk_s(p0[10], p0[11]), cvtpk_s(p0[12], p0[13]), cvtpk_s(p0[14], p0[15])};
        pw2 = (v4u){cvtpk_s(p1[0], p1[1]), cvtpk_s(p1[2], p1[3]), cvtpk_s(p1[4], p1[5]), cvtpk_s(p1[6], p1[7])};
        pw3 = (v4u){cvtpk_s(p1[8], p1[9]), cvtpk_s(p1[10], p1[11]), cvtpk_s(p1[12], p1[13]), cvtpk_s(p1[14], p1[15])};
        __builtin_amdgcn_sched_barrier(0);
        pv(o, vb0, __builtin_bit_cast(bf16x8, pw0), __builtin_bit_cast(bf16x8, pw1), __builtin_bit_cast(bf16x8, pw2), __builtin_bit_cast(bf16x8, pw3));
        asm volatile("s_waitcnt lgkmcnt(0)\n\ts_barrier" ::: "memory");
    }
    { auto rr = __builtin_amdgcn_permlane32_swap(__float_as_uint(lsum), __float_as_uint(lsum), false, false); lsum = __uint_as_float(rr[0]) + __uint_as_float(rr[1]); }
    if (hi == 0) wsf[32 + r32] = lsum;
    asm volatile("s_waitcnt lgkmcnt(0)" ::: "memory");
    float rli[16];
#pragma unroll
    for (int r = 0; r < 16; ++r) rli[r] = __builtin_amdgcn_rcpf(wsf[32 + crow(r, hi)]);
    bf16* Ow = OA + (rowbase + q0 + wid * 32) * AW + h * 64;
    { LAS bf16* stg = (LAS bf16*)(shm + LDS_OST) + wid * 2048;
#pragma unroll
        for (int r = 0; r < 16; ++r) { const int orow = crow(r, hi);
#pragma unroll
            for (int d0 = 0; d0 < 2; ++d0) stg[orow * 64 + d0 * 32 + r32] = (bf16)(cvtpk_s(o[d0][r] * rli[r], 0.f) & 0xffffu); }
        asm volatile("s_waitcnt lgkmcnt(0)" ::: "memory");
#pragma unroll
        for (int i = 0; i < 4; ++i) { const int row = i * 8 + (lane >> 3), ch = lane & 7; const v4u v = *(const LAS v4u*)(stg + row * 64 + ch * 8); *(v4u*)(Ow + (long)row * AW + ch * 8) = v; } }
    asm volatile("s_waitcnt lgkmcnt(0)\n\ts_barrier" ::: "memory");
}
}

__device__ __forceinline__ void sattn_unit(Ctx& C, int db, int rg) {
    const int lane = C.lane, h = C.wave, q = lane & 15, fq = lane >> 4;
    const bf16* U = (const bf16*)(C.ws + WS_U);
    const int* pt = (const int*)C.in[I_PT];
    const float* SBh = (const float*)(C.ws + WS_SB) + (size_t)(db * AH + h) * PAST + rg * 1024;
    float qf[4][4];
    { const bf16* qrow = U + (size_t)(MP + db * DS + (q & 7)) * NU + UC_QA + h * 64;
#pragma unroll
      for (int m = 0; m < 4; ++m) { const v2u w = *(const v2u*)(qrow + (4 * m + fq) * 4);
          qf[m][0] = q < 8 ? bflo(w.x) : 0.f; qf[m][1] = q < 8 ? bfhi(w.x) : 0.f; qf[m][2] = q < 8 ? bflo(w.y) : 0.f; qf[m][3] = q < 8 ? bfhi(w.y) : 0.f; } }
    float mrun = -INFINITY, lsum = 0.f; f32x4 o[4];
#pragma unroll
    for (int j = 0; j < 4; ++j) o[j] = (f32x4){0.f, 0.f, 0.f, 0.f};
    for (int blk = 0; blk < 64; ++blk) {
        const int pg = pt[db * NPAGES + rg * 8 + (blk >> 3)]; const size_t tok0 = (size_t)pg * PAGE + (blk & 7) * 16;
        const float* Kb = INF(I_CK) + tok0 * AW + h * 64; const float* Vb = INF(I_CV) + tok0 * AW + h * 64;
        f32x4 kk[4], vv[4];
#pragma unroll
        for (int m = 0; m < 4; ++m) kk[m] = *(const f32x4*)(Kb + (size_t)q * AW + (4 * m + fq) * 4);
#pragma unroll
        for (int r4 = 0; r4 < 4; ++r4) vv[r4] = *(const f32x4*)(Vb + (size_t)(4 * fq + r4) * AW + q * 4);
        f32x4 s = *(const f32x4*)(SBh + blk * 16 + 4 * fq);
#pragma unroll
        for (int m = 0; m < 4; ++m)
#pragma unroll
            for (int j = 0; j < 4; ++j) s = __builtin_amdgcn_mfma_f32_16x16x4f32(kk[m][j], qf[m][j], s, 0, 0, 0);
        float rm = fmaxf(fmaxf(s[0], s[1]), fmaxf(s[2], s[3]));
        rm = fmaxf(rm, __shfl_xor(rm, 16)); rm = fmaxf(rm, __shfl_xor(rm, 32));
        const float mn = fmaxf(mrun, rm); const float f = __builtin_amdgcn_exp2f(mrun - mn); mrun = mn;
        f32x4 p;
#pragma unroll
        for (int i = 0; i < 4; ++i) p[i] = __builtin_amdgcn_exp2f(s[i] - mn);
        lsum = lsum * f + (p[0] + p[1]) + (p[2] + p[3]);
#pragma unroll
        for (int j = 0; j < 4; ++j) o[j] = o[j] * f;
#pragma unroll
        for (int r4 = 0; r4 < 4; ++r4)
#pragma unroll
            for (int j = 0; j < 4; ++j) o[j] = __builtin_amdgcn_mfma_f32_16x16x4f32(vv[r4][j], p[r4], o[j], 0, 0, 0);
    }
    lsum += __shfl_xor(lsum, 16); lsum += __shfl_xor(lsum, 32);
    if (q < 8) {
        float* dst = (float*)(C.ws + WS_PART) + ((size_t)((db * 8 + rg) * AH + h) * DS + q) * PART_STRIDE;
        if (fq == 0) { dst[0] = mrun; dst[1] = lsum; }
#pragma unroll
        for (int j = 0; j < 4; ++j)
#pragma unroll
            for (int r = 0; r < 4; ++r) dst[4 + 4 * (4 * fq + r) + j] = o[j][r];
    }
}
__device__ __forceinline__ void sattn_combine(Ctx& C) {
    const bf16* U = (const bf16*)(C.ws + WS_U); bf16* OA = (bf16*)(C.ws + WS_OA);
    const int gw = C.bid * NWAVES + C.wave, NGW = C.G * NWAVES, d = C.lane;
    for (int it = gw; it < DB * AH * DS; it += NGW) {
        const int db = it >> 6, h = (it >> 3) & 7, q = it & 7;
        const float qd = bf2f(U[(size_t)(MP + db * DS + q) * NU + UC_QA + h * 64 + d]);
        float sn[8]; float cn = 0.f; float M = -INFINITY;
#pragma unroll
        for (int j = 0; j < 8; ++j) {
            cn += C.out[OFF_FS + (size_t)(db * DS + j) * AH + h];
            const float kd = C.out[OFF_KS + (size_t)(db * DS + j) * AW + h * 64 + d];
            const float s = wave_sum(qd * kd) - cn * LOG2E;
            sn[j] = j <= q ? s : -INFINITY; M = fmaxf(M, sn[j]);
        }
        float pm[8], pl[8];
#pragma unroll
        for (int r = 0; r < 8; ++r) { const float* src = (const float*)(C.ws + WS_PART) + ((size_t)((db * 8 + r) * AH + h) * DS + q) * PART_STRIDE; pm[r] = src[0]; pl[r] = src[1]; M = fmaxf(M, pm[r]); }
        float L = 0.f, O = 0.f;
#pragma unroll
        for (int r = 0; r < 8; ++r) { const float* src = (const float*)(C.ws + WS_PART) + ((size_t)((db * 8 + r) * AH + h) * DS + q) * PART_STRIDE; const float w = __builtin_amdgcn_exp2f(pm[r] - M); L += pl[r] * w; O += src[4 + d] * w; }
#pragma unroll
        for (int j = 0; j < 8; ++j) { const float w = __builtin_amdgcn_exp2f(sn[j] - M); L += w; O += w * C.out[OFF_VS + (size_t)(db * DS + j) * AW + h * 64 + d]; }
        OA[(size_t)(MP + db * DS + q) * AW + h * 64 + d] = (bf16)f2bf(O / L);
    }
}


namespace gla {
constexpr int QSTR = 136, TSTR = 72;
constexpr int L_ALB = 0, L_W2 = 4096, L_BA = 12288, L_PRE = 12800, L_D = 14848, L_QS = 15360, L_KS = 32768, L_KLT = 50176, L_VT = 68608, L_BC = 105472, L_END = 138240;
__device__ __forceinline__ int perm16(int x) { return (x & ~15) | (((x >> 2) & 1) << 3) | (((x >> 3) & 1) << 2) | (x & 3); }
__device__ __forceinline__ int crow(int r, int hi) { return (r & 3) + 8 * (r >> 2) + 4 * hi; }
typedef float f32x2_t __attribute__((ext_vector_type(2))); typedef __bf16 bf16x2_t __attribute__((ext_vector_type(2)));
__device__ __forceinline__ unsigned cvtv(float lo, float hi) { f32x2_t v = {lo, hi}; bf16x2_t b = __builtin_convertvector(v, bf16x2_t); return __builtin_bit_cast(unsigned, b); }
__device__ __forceinline__ bf16x8 packacc(const f32x16& a, int s) {
    v4u w;
    if (s == 0) { w.x = cvtv(a[0], a[1]); w.y = cvtv(a[2], a[3]); w.z = cvtv(a[4], a[5]); w.w = cvtv(a[6], a[7]); }
    else        { w.x = cvtv(a[8], a[9]); w.y = cvtv(a[10], a[11]); w.z = cvtv(a[12], a[13]); w.w = cvtv(a[14], a[15]); }
    return __builtin_bit_cast(bf16x8, w);
}
__device__ __forceinline__ void load_head(Ctx& C, int h) {
    LAS float* W2 = (LAS float*)(C.lds + L_W2); LAS float* BA = (LAS float*)(C.lds + L_BA);
    __syncthreads();
    for (int e = C.tid; e < 2048; e += NTHR) W2[e] = INF(I_WA2)[(e >> 7) * BKW + h * 128 + (e & 127)];
    if (C.tid < 128) BA[C.tid] = INF(I_BA)[h * 128 + C.tid];
}
template <bool NEED_QK> __device__ __forceinline__ void stage_chunk(Ctx& C, int row_c0, int nvalid, int h) {
    const bf16* U = (const bf16*)(C.ws + WS_U); const float* alow = (const float*)(C.ws + WS_ALOW);
    LAS float* ALB = (LAS float*)(C.lds + L_ALB); LAS float* W2 = (LAS float*)(C.lds + L_W2); LAS float* BA = (LAS float*)(C.lds + L_BA);
    LAS float* PRE = (LAS float*)(C.lds + L_PRE); LAS float* Dv = (LAS float*)(C.lds + L_D); LAS float* BC = (LAS float*)(C.lds + L_BC);
    LAS bf16* QS = (LAS bf16*)(C.lds + L_QS); LAS bf16* KS = (LAS bf16*)(C.lds + L_KS); LAS bf16* KLT = (LAS bf16*)(C.lds + L_KLT); LAS bf16* VT = (LAS bf16*)(C.lds + L_VT);
    const int tid = C.tid, i = tid & 127, tq = tid >> 7;
    __syncthreads();
#pragma unroll
    for (int n = 0; n < 2; ++n) { const int e = tid + NTHR * n; ALB[e] = (e >> 4) < nvalid ? alow[(size_t)row_c0 * GR + e] : 0.f; }
#pragma unroll
    for (int n = 0; n < 4; ++n) { const int e = tid + NTHR * n, t = e & 63, vg = e >> 6;
        v4u w = (v4u){0u, 0u, 0u, 0u};
        if (t < nvalid) w = *(const v4u*)(U + (size_t)(row_c0 + t) * NU + UC_VB + h * 256 + vg * 8);
        LAS bf16* d = VT + (vg * 8) * TSTR + perm16(t);
        d[0] = (bf16)(w.x & 0xffffu); d[TSTR] = (bf16)(w.x >> 16); d[2 * TSTR] = (bf16)(w.y & 0xffffu); d[3 * TSTR] = (bf16)(w.y >> 16);
        d[4 * TSTR] = (bf16)(w.z & 0xffffu); d[5 * TSTR] = (bf16)(w.z >> 16); d[6 * TSTR] = (bf16)(w.w & 0xffffu); d[7 * TSTR] = (bf16)(w.w >> 16); }
    __syncthreads();
    {
        float w2[16];
#pragma unroll
        for (int r = 0; r < 16; ++r) w2[r] = W2[r * 128 + i];
        const float ba = BA[i]; float run = 0.f;
#pragma unroll 4
        for (int tt = 0; tt < 16; ++tt) { const int t = 16 * tq + tt; float x = ba;
            const f32x4 a0 = *(const LAS f32x4*)(ALB + t * 16), a1 = *(const LAS f32x4*)(ALB + t * 16 + 4), a2 = *(const LAS f32x4*)(ALB + t * 16 + 8), a3 = *(const LAS f32x4*)(ALB + t * 16 + 12);
            x += a0[0] * w2[0] + a0[1] * w2[1] + a0[2] * w2[2] + a0[3] * w2[3]; x += a1[0] * w2[4] + a1[1] * w2[5] + a1[2] * w2[6] + a1[3] * w2[7];
            x += a2[0] * w2[8] + a2[1] * w2[9] + a2[2] * w2[10] + a2[3] * w2[11]; x += a3[0] * w2[12] + a3[1] * w2[13] + a3[2] * w2[14] + a3[3] * w2[15];
            const float la = (fminf(x, 0.f) - __logf(1.f + __expf(-fabsf(x)))) * (1.f / 16.f);
            run += (t < nvalid) ? la : 0.f; BC[t * 128 + i] = run; }
        PRE[tq * 128 + i] = run;
    }
    __syncthreads();
    {
        const float p0 = PRE[i], p1 = PRE[128 + i], p2 = PRE[256 + i], p3 = PRE[384 + i];
        const float tot = (p0 + p1) + (p2 + p3);
        if (tq == 0) Dv[i] = __expf(tot);
        const int pi = perm16(i);
#pragma unroll 4
        for (int n = 0; n < 16; ++n) { const int t = tq + 4 * n; const int q4 = n >> 2;
            const float pre = q4 == 0 ? 0.f : (q4 == 1 ? p0 : (q4 == 2 ? p0 + p1 : p0 + p1 + p2));
            const float B = BC[t * 128 + i] + pre;
            const size_t ro = (size_t)(row_c0 + t) * NU;
            const float kv = t < nvalid ? bf2f(U[ro + UC_KB + h * 128 + i]) : 0.f;
            KLT[i * TSTR + perm16(t)] = (bf16)f2bf(kv * __expf(tot - B));
            if (NEED_QK) { const float qv = t < nvalid ? bf2f(U[ro + UC_QB + h * 128 + i]) : 0.f; const float e1 = __expf(B);
                QS[t * QSTR + pi] = (bf16)f2bf(qv * e1); KS[t * QSTR + pi] = (bf16)f2bf(kv * __expf(-B)); } }
    }
    __syncthreads();
}
template <bool OUT, bool UPD> __device__ __forceinline__ void mma_chunk(Ctx& C, f32x16 (&acc)[4], int row_c0, int nvalid, int h) {
    const int lane = C.lane, w = C.wave, r32 = lane & 31, hi = lane >> 5;
    const LAS bf16* QS = (const LAS bf16*)(C.lds + L_QS); const LAS bf16* KS = (const LAS bf16*)(C.lds + L_KS);
    const LAS bf16* KLT = (const LAS bf16*)(C.lds + L_KLT); const LAS bf16* VT = (const LAS bf16*)(C.lds + L_VT); const LAS float* Dv = (const LAS float*)(C.lds + L_D);
    bf16x8 vt[4];
#pragma unroll
    for (int ks = 0; ks < 4; ++ks) vt[ks] = *(const LAS bf16x8*)(VT + (32 * w + r32) * TSTR + 16 * ks + 8 * hi);
    if (OUT) {
        char* OBRb = (char*)((float*)(C.ws + WS_OBR) + (size_t)row_c0 * BVW + h * 256 + 32 * w);
        const unsigned ovoff = (unsigned)((4 * hi) * BVW + r32) * 4u;
        f32x16 o0 = f32x16{}, o1 = f32x16{};
#pragma unroll
        for (int rt = 0; rt < 4; ++rt)
#pragma unroll
            for (int s = 0; s < 2; ++s) { const bf16x8 bfr = packacc(acc[rt], s);
                const bf16x8 a0 = *(const LAS bf16x8*)(QS + r32 * QSTR + 32 * rt + 16 * s + 8 * hi), a1 = *(const LAS bf16x8*)(QS + (32 + r32) * QSTR + 32 * rt + 16 * s + 8 * hi);
                o0 = __builtin_amdgcn_mfma_f32_32x32x16_bf16(a0, bfr, o0, 0, 0, 0); o1 = __builtin_amdgcn_mfma_f32_32x32x16_bf16(a1, bfr, o1, 0, 0, 0); }
        __builtin_amdgcn_sched_barrier(0);
        {
            f32x16 X = f32x16{};
#pragma unroll
            for (int kk = 0; kk < 8; ++kk) { const bf16x8 k0 = *(const LAS bf16x8*)(KS + r32 * QSTR + 16 * kk + 8 * hi), q0 = *(const LAS bf16x8*)(QS + r32 * QSTR + 16 * kk + 8 * hi);
                X = __builtin_amdgcn_mfma_f32_32x32x16_bf16(k0, q0, X, 0, 0, 0); }
#pragma unroll
            for (int r = 0; r < 16; ++r) { if (crow(r, hi) > r32) X[r] = 0.f; }
            o0 = __builtin_amdgcn_mfma_f32_32x32x16_bf16(packacc(X, 0), vt[0], o0, 0, 0, 0); o0 = __builtin_amdgcn_mfma_f32_32x32x16_bf16(packacc(X, 1), vt[1], o0, 0, 0, 0);
#pragma unroll
            for (int r = 0; r < 16; ++r) { const int tu = (r & 3) + 8 * (r >> 2); if (tu + 4 * hi < nvalid) *(float*)(OBRb + (size_t)tu * BVW * 4 + ovoff) = o0[r]; }
        }
        __builtin_amdgcn_sched_barrier(0);
        if (nvalid > 32) {
            f32x16 X01 = f32x16{}, X11 = f32x16{};
#pragma unroll
            for (int kk = 0; kk < 8; ++kk) {
                const bf16x8 k0 = *(const LAS bf16x8*)(KS + r32 * QSTR + 16 * kk + 8 * hi), k1 = *(const LAS bf16x8*)(KS + (32 + r32) * QSTR + 16 * kk + 8 * hi);
                const bf16x8 q1 = *(const LAS bf16x8*)(QS + (32 + r32) * QSTR + 16 * kk + 8 * hi);
                X01 = __builtin_amdgcn_mfma_f32_32x32x16_bf16(k0, q1, X01, 0, 0, 0); X11 = __builtin_amdgcn_mfma_f32_32x32x16_bf16(k1, q1, X11, 0, 0, 0); }
#pragma unroll
            for (int r = 0; r < 16; ++r) { if (crow(r, hi) > r32) X11[r] = 0.f; }
            o1 = __builtin_amdgcn_mfma_f32_32x32x16_bf16(packacc(X01, 0), vt[0], o1, 0, 0, 0); o1 = __builtin_amdgcn_mfma_f32_32x32x16_bf16(packacc(X01, 1), vt[1], o1, 0, 0, 0);
            o1 = __builtin_amdgcn_mfma_f32_32x32x16_bf16(packacc(X11, 0), vt[2], o1, 0, 0, 0); o1 = __builtin_amdgcn_mfma_f32_32x32x16_bf16(packacc(X11, 1), vt[3], o1, 0, 0, 0);
#pragma unroll
            for (int r = 0; r < 16; ++r) { const int tu = 32 + (r & 3) + 8 * (r >> 2); if (tu + 4 * hi < nvalid) *(float*)(OBRb + (size_t)tu * BVW * 4 + ovoff) = o1[r]; }
        }
    }
    __builtin_amdgcn_sched_barrier(0);
    if (UPD) {
#pragma unroll
        for (int rt = 0; rt < 4; ++rt) {
            __builtin_amdgcn_sched_barrier(0);
#pragma unroll
            for (int r = 0; r < 16; ++r) acc[rt][r] *= Dv[32 * rt + crow(r, hi)];
#pragma unroll
            for (int ks = 0; ks < 4; ++ks) { const bf16x8 a = *(const LAS bf16x8*)(KLT + (32 * rt + r32) * TSTR + 16 * ks + 8 * hi); acc[rt] = __builtin_amdgcn_mfma_f32_32x32x16_bf16(a, vt[ks], acc[rt], 0, 0, 0); }
        }
    }
}
__device__ __forceinline__ void load_state(f32x16 (&acc)[4], const float* S, int w, int r32, int hi) {
    const unsigned voff = (unsigned)((4 * hi) * BV + 32 * w + r32) * 4u;
#pragma unroll
    for (int rt = 0; rt < 4; ++rt) {
#pragma unroll
        for (int g = 0; g < 4; ++g) { const char* sb = (const char*)S + (size_t)(32 * rt + 8 * g) * BV * 4;
#pragma unroll
            for (int j = 0; j < 4; ++j) acc[rt][4 * g + j] = *(const float*)(sb + voff + j * BV * 4); }
        asm volatile("" ::: "memory");
    }
}
__device__ __forceinline__ void store_state(const f32x16 (&acc)[4], float* S, int w, int r32, int hi) {
    const unsigned voff = (unsigned)((4 * hi) * BV + 32 * w + r32) * 4u;
#pragma unroll
    for (int rt = 0; rt < 4; ++rt) {
#pragma unroll
        for (int g = 0; g < 4; ++g) { char* sb = (char*)S + (size_t)(32 * rt + 8 * g) * BV * 4;
#pragma unroll
            for (int j = 0; j < 4; ++j) *(float*)(sb + voff + j * BV * 4) = acc[rt][4 * g + j]; }
        asm volatile("" ::: "memory");
    }
}
__device__ __forceinline__ void b1_unit(Ctx& C, int u) {
    const int sc = u & 31, bh = u >> 5, h = bh & 3, b = bh >> 2; const int row0 = b * SEQ + sc * 256;
    const int r32 = C.lane & 31, hi = C.lane >> 5;
    load_head(C, h);
    f32x16 acc[4]; acc[0] = f32x16{}; acc[1] = f32x16{}; acc[2] = f32x16{}; acc[3] = f32x16{};
    float dprod = 1.f;
#pragma unroll 1
    for (int c = 0; c < 4; ++c) { stage_chunk<false>(C, row0 + 64 * c, 64, h); if (C.tid < 128) dprod *= ((const LAS float*)(C.lds + L_D))[C.tid]; mma_chunk<false, true>(C, acc, row0 + 64 * c, 64, h); }
    store_state(acc, (float*)(C.ws + WS_LS) + (size_t)u * BK_ * BV, C.wave, r32, hi);
    if (C.tid < 128) ((float*)(C.ws + WS_DSC))[u * 128 + C.tid] = dprod;
}
__device__ __forceinline__ void b2_scan(Ctx& C) {
    float* LS = (float*)(C.ws + WS_LS); const float* DSC = (const float*)(C.ws + WS_DSC);
    for (int q = C.bid * NTHR + C.tid; q < NB * BH * BK_ * BV / 4; q += C.G * NTHR) {
        const int bh = q >> 13, rem = q & 8191, i = rem >> 6, v4 = (rem & 63) * 4;
        f32x4 s = (f32x4){0.f, 0.f, 0.f, 0.f};
#pragma unroll 4
        for (int sc = 0; sc < 32; ++sc) { const int u = bh * 32 + sc; f32x4* p = (f32x4*)(LS + ((size_t)u * BK_ + i) * BV + v4); const float d = DSC[u * 128 + i]; s = s * d + *p; *p = s; }
        *(f32x4*)(C.out + OFF_GP + ((size_t)bh * BK_ + i) * BV + v4) = s;
    }
}
__device__ __forceinline__ void b3_unit(Ctx& C, int u) {
    const int sc = u & 31, bh = u >> 5, h = bh & 3, b = bh >> 2; const int row0 = b * SEQ + sc * 256;
    const int r32 = C.lane & 31, hi = C.lane >> 5;
    load_head(C, h);
    f32x16 acc[4];
    if (sc == 0) { acc[0] = f32x16{}; acc[1] = f32x16{}; acc[2] = f32x16{}; acc[3] = f32x16{}; }
    else load_state(acc, (const float*)(C.ws + WS_LS) + (size_t)(u - 1) * BK_ * BV, C.wave, r32, hi);
#pragma unroll 1
    for (int c = 0; c < 4; ++c) { stage_chunk<true>(C, row0 + 64 * c, 64, h); mma_chunk<true, true>(C, acc, row0 + 64 * c, 64, h); }
}
__device__ __forceinline__ void sample_unit(Ctx& C, int u) {
    const int h = u & 3, db = u >> 2; const int row0 = MP + db * DS;
    const int r32 = C.lane & 31, hi = C.lane >> 5;
    load_head(C, h);
    f32x16 acc[4];
    load_state(acc, INF(I_SG) + (size_t)u * BK_ * BV, C.wave, r32, hi);
    stage_chunk<true>(C, row0, DS, h); mma_chunk<true, true>(C, acc, row0, DS, h);
    store_state(acc, C.out + OFF_GS + (size_t)u * BK_ * BV, C.wave, r32, hi);
}
}
__device__ __forceinline__ void gla_post(Ctx& C) {
    const bf16* U = (const bf16*)(C.ws + WS_U); const float* OBR = (const float*)(C.ws + WS_OBR); bf16* OB = (bf16*)(C.ws + WS_OB);
    const int gw = C.bid * NWAVES + C.wave, NGW = C.G * NWAVES;
    const f32x4 gg = *(const f32x4*)(INF(I_GGLA) + C.lane * 4);
    for (int m = gw; m < MT; m += NGW) {
#pragma unroll
        for (int h = 0; h < 4; ++h) {
            const f32x4 x = *(const f32x4*)(OBR + (size_t)m * BVW + h * 256 + C.lane * 4);
            const float r = 1.f / sqrtf(wave_sum((x[0] * x[0] + x[1] * x[1]) + (x[2] * x[2] + x[3] * x[3])) * (1.f / 256.f) + EPS);
            const v2u rb = *(const v2u*)(U + (size_t)m * NU + UC_RB + h * 256 + C.lane * 4);
            const float r0 = bflo(rb.x), r1 = bfhi(rb.x), r2 = bflo(rb.y), r3 = bfhi(rb.y);
            v2u w; w.x = pk2(x[0] * r * gg[0] * r0 * sigmoidf_(r0), x[1] * r * gg[1] * r1 * sigmoidf_(r1)); w.y = pk2(x[2] * r * gg[2] * r2 * sigmoidf_(r2), x[3] * r * gg[3] * r3 * sigmoidf_(r3));
            *(v2u*)(OB + (size_t)m * BVW + h * 256 + C.lane * 4) = w;
        }
    }
}

__device__ __forceinline__ void p7_rows(Ctx& C) {
    const float* F1 = (const float*)(C.ws + WS_F1); float* X1 = (float*)(C.ws + WS_X1); bf16* XN2 = (bf16*)(C.ws + WS_XN2);
    const int gw = C.bid * NWAVES + C.wave, NGW = C.G * NWAVES, lane = C.lane;
    for (int m = gw; m < MT; m += NGW) {
        const float* xr = m < MP ? INF(I_XP) + (size_t)m * DM : INF(I_XS) + (size_t)(m - MP) * DM;
        f32x4 f[4], x[4]; float s = 0.f;
#pragma unroll
        for (int j = 0; j < 4; ++j) { f[j] = *((const f32x4*)(F1 + (size_t)m * DM) + lane + 64 * j); x[j] = *((const f32x4*)xr + lane + 64 * j); s += (f[j].x * f[j].x + f[j].y * f[j].y) + (f[j].z * f[j].z + f[j].w * f[j].w); }
        const float r = 1.f / sqrtf(wave_sum(s) * (1.f / DM) + EPS); float s2 = 0.f;
#pragma unroll
        for (int j = 0; j < 4; ++j) { const f32x4 g = *((const f32x4*)INF(I_GPOM) + lane + 64 * j); x[j] = x[j] + f[j] * r * g; s2 += (x[j].x * x[j].x + x[j].y * x[j].y) + (x[j].z * x[j].z + x[j].w * x[j].w);
            *((f32x4*)(X1 + (size_t)m * DM) + lane + 64 * j) = x[j]; }
        const float r2 = 1.f / sqrtf(wave_sum(s2) * (1.f / DM) + EPS);
#pragma unroll
        for (int j = 0; j < 4; ++j) { const f32x4 g = *((const f32x4*)INF(I_GPF) + lane + 64 * j); v2u w; w.x = pk2(x[j].x * r2 * g.x, x[j].y * r2 * g.y); w.y = pk2(x[j].z * r2 * g.z, x[j].w * r2 * g.w);
            *((v2u*)(XN2 + (size_t)m * DM) + lane + 64 * j) = w; }
    }
}
__device__ __forceinline__ void p11_rows(Ctx& C) {
    const float* F2 = (const float*)(C.ws + WS_F2); const float* X1 = (const float*)(C.ws + WS_X1);
    const int gw = C.bid * NWAVES + C.wave, NGW = C.G * NWAVES, lane = C.lane;
    for (int m = gw; m < MT; m += NGW) {
        f32x4 f[4]; float s = 0.f;
#pragma unroll
        for (int j = 0; j < 4; ++j) { f[j] = *((const f32x4*)(F2 + (size_t)m * DM) + lane + 64 * j); s += (f[j].x * f[j].x + f[j].y * f[j].y) + (f[j].z * f[j].z + f[j].w * f[j].w); }
        const float r = 1.f / sqrtf(wave_sum(s) * (1.f / DM) + EPS);
#pragma unroll
        for (int j = 0; j < 4; ++j) { const f32x4 g = *((const f32x4*)INF(I_GPOF) + lane + 64 * j); const f32x4 x = *((const f32x4*)(X1 + (size_t)m * DM) + lane + 64 * j);
            *((f32x4*)(C.out + OFF_YP + (size_t)m * DM) + lane + 64 * j) = x + f[j] * r * g; }
    }
}
__device__ __forceinline__ float gelu_tanh(float g) { const float u = 0.7978845608028654f * (g + 0.044715f * g * g * g); const float e = __expf(2.f * u); const float th = 1.f - 2.f / (e + 1.f); return 0.5f * g * (1.f + th); }
__device__ __forceinline__ void p9_conv(Ctx& C) {
    const bf16* UU = (const bf16*)(C.ws + WS_UU); bf16* ACT = (bf16*)(C.ws + WS_ACT);
    const float* wc = INF(I_WCONV); const float* bc = INF(I_BCONV);
    constexpr int NG = DFF / 8;
    const long total = (long)MT * NG;
    for (long it = (long)C.bid * NTHR + C.tid; it < total; it += (long)C.G * NTHR) {
        const int m = (int)(it / NG), j0 = (int)(it % NG) * 8;
        int t; const float* sc = nullptr;
        if (m < MP) t = m & (SEQ - 1); else { t = (m - MP) & 7; sc = INF(I_SC) + (size_t)((m - MP) >> 3) * 2 * DFF2; }
        float res[2][8];
#pragma unroll
        for (int half = 0; half < 2; ++half) {
            const int c0 = half * DFF + j0;
            float acc[8];
#pragma unroll
            for (int i = 0; i < 8; ++i) acc[i] = bc[c0 + i];
#pragma unroll
            for (int k = 0; k < 3; ++k) {
                const int tt = t - 2 + k; float xv[8];
                if (tt >= 0) { const v4u w = *(const v4u*)(UU + (size_t)(m - 2 + k) * DFF2 + c0);
                    xv[0] = bflo(w.x); xv[1] = bfhi(w.x); xv[2] = bflo(w.y); xv[3] = bfhi(w.y); xv[4] = bflo(w.z); xv[5] = bfhi(w.z); xv[6] = bflo(w.w); xv[7] = bfhi(w.w); }
                else if (sc) { const float* s = sc + (size_t)(tt + 2) * DFF2 + c0;
#pragma unroll
                    for (int i = 0; i < 8; ++i) xv[i] = s[i]; }
                else {
#pragma unroll
                    for (int i = 0; i < 8; ++i) xv[i] = 0.f; }
#pragma unroll
                for (int i = 0; i < 8; ++i) acc[i] += xv[i] * wc[(size_t)k * DFF2 + c0 + i];
            }
#pragma unroll
            for (int i = 0; i < 8; ++i) res[half][i] = acc[i];
        }
        v4u w;
        w.x = pk2(gelu_tanh(res[1][0]) * res[0][0], gelu_tanh(res[1][1]) * res[0][1]); w.y = pk2(gelu_tanh(res[1][2]) * res[0][2], gelu_tanh(res[1][3]) * res[0][3]);
        w.z = pk2(gelu_tanh(res[1][4]) * res[0][4], gelu_tanh(res[1][5]) * res[0][5]); w.w = pk2(gelu_tanh(res[1][6]) * res[0][6], gelu_tanh(res[1][7]) * res[0][7]);
        *(v4u*)(ACT + (size_t)m * DFF + j0) = w;
    }
}

constexpr int NPHASE = 14;
struct Args { const void* in[24]; float* out; unsigned char* ws; int ph_lo, ph_hi; };
__global__ void __launch_bounds__(NTHR, 2) mk_fwd(Args args) {
    extern __shared__ __attribute__((aligned(16))) unsigned char lds[];
    Ctx C;
    C.lds = (LAS unsigned char*)lds;
    C.tid = threadIdx.x; C.lane = C.tid & 63; C.wave = __builtin_amdgcn_readfirstlane(C.tid >> 6);
    C.G = gridDim.x; C.bid = blockIdx.x;
#pragma unroll
    for (int i = 0; i < 24; ++i) C.in[i] = (const float*)args.in[i];
    C.out = args.out; C.ws = args.ws;
    unsigned char* ws = args.ws;
    for (int u = C.tid; u < (LDS_BYTES - LDSCTL_OFF) / 4; u += NTHR) ((LAS unsigned*)(C.lds + LDSCTL_OFF))[u] = 0u;
    __syncthreads();
    const int lo = args.ph_lo, hi = args.ph_hi;
    const bool multi = (hi - lo) > 1;
    XcdBarrier bar; bar.bar = (unsigned*)(ws + WS_CTL) + CW_BAR; bar.x = 0; bar.st = nullptr;
    if (multi) bar = xcd_barrier_post((unsigned*)(ws + WS_CTL) + CW_BAR, (volatile LAS unsigned*)(C.lds + MISC_OFF) + 8);
#ifndef PHASE_MASK
#define PHASE_MASK 0xFFFF
#endif
#define IN(k) (((PHASE_MASK >> (k)) & 1) && lo <= (k) && (k) < hi)
#define SEAM(k) do { if (IN(k) && IN((k) + 1)) xcd_barrier(bar); } while (0)
    bf16* U = (bf16*)(ws + WS_U);

    if (IN(0)) { p0_prologue(C); } SEAM(0);

    if (IN(1)) {
        pg8::Gemm g{(const bf16*)(ws + WS_XN), (const bf16*)(ws + WS_WIN), MT, NU, DM}; pg8::StaticOrder S; S.init(MT, NU, C.G, C.bid);
        pg8::EpiGen<StInProj> E{{U, C.out, (float*)(ws + WS_ALOW), (float*)(ws + WS_FA)}};
        pg8::gemm_phase<pg8::EpiGen<StInProj>, pg8::StaticOrder, true, true>(C.lds + RING_OFF, g, S, E);
    } SEAM(1);

    if (IN(2)) { p2_scans(C); for (int u = C.bid; u < 256; u += C.G) gla::b1_unit(C, u); } SEAM(2);

    if (IN(3)) {
        gla::b2_scan(C);
        for (int u = C.bid; u < 512 + 256 + 128; u += C.G) {
            if (u < 512) { const int qb = 31 - (u >> 4), bh = u & 15; att::attn_unit(bh >> 3, bh & 7, qb, U, (const float*)(ws + WS_CB), (bf16*)(ws + WS_OA), C.lds + RING_OFF); }
            else if (u < 768) { const int w = u - 512; sattn_unit(C, w >> 3, w & 7); }
            else gla::sample_unit(C, u - 768);
        }
    } SEAM(3);

    if (IN(4)) { for (int u = C.bid; u < 256; u += C.G) gla::b3_unit(C, u); sattn_combine(C); } SEAM(4);

    if (IN(5)) { gla_post(C); } SEAM(5);

    if (IN(6)) {
        pg8::Gemm g{(const bf16*)(ws + WS_OA), (const bf16*)(ws + WS_WPA), MT, DM, AW}; pg8::StaticOrder S; S.init(MT, DM, C.G, C.bid);
        pg8::EpiGen<StProjA> E{{U, (float*)(ws + WS_TA)}};
        pg8::gemm_phase<pg8::EpiGen<StProjA>, pg8::StaticOrder, true, true>(C.lds + RING_OFF, g, S, E);
    } SEAM(6);

    if (IN(7)) {
        pg8::Gemm g{(const bf16*)(ws + WS_OB), (const bf16*)(ws + WS_WPB), MT, DM, BVW}; pg8::StaticOrder S; S.init(MT, DM, C.G, C.bid);
        pg8::EpiGen<StProjB> E{{U, (const float*)(ws + WS_TA), (bf16*)(ws + WS_MG)}};
        pg8::gemm_phase<pg8::EpiGen<StProjB>, pg8::StaticOrder, true, true>(C.lds + RING_OFF, g, S, E);
    } SEAM(7);

    if (IN(8)) {
        pg8::Gemm g{(const bf16*)(ws + WS_MG), (const bf16*)(ws + WS_WOUT), MT, DM, DM}; pg8::StaticOrder S; S.init(MT, DM, C.G, C.bid);
        pg8::EpiGen<StF32> E{{(float*)(ws + WS_F1)}};
        pg8::gemm_phase<pg8::EpiGen<StF32>, pg8::StaticOrder, true, true>(C.lds + RING_OFF, g, S, E);
    } SEAM(8);

    if (IN(9)) { p7_rows(C); } SEAM(9);

    if (IN(10)) {
        pg8::Gemm g{(const bf16*)(ws + WS_XN2), (const bf16*)(ws + WS_WUP), MT, DFF2, DM}; pg8::StaticOrder S; S.init(MT, DFF2, C.G, C.bid);
        pg8::EpiGen<StUp> E{{(bf16*)(ws + WS_UU), C.out}};
        pg8::gemm_phase<pg8::EpiGen<StUp>, pg8::StaticOrder, true, true>(C.lds + RING_OFF, g, S, E);
    } SEAM(10);

    if (IN(11)) { p9_conv(C); } SEAM(11);

    if (IN(12)) {
        pg8::Gemm g{(const bf16*)(ws + WS_ACT), (const bf16*)(ws + WS_WDN), MT, DM, DFF}; pg8::StaticOrder S; S.init(MT, DM, C.G, C.bid);
        pg8::EpiGen<StF32> E{{(float*)(ws + WS_F2)}};
        pg8::gemm_phase<pg8::EpiGen<StF32>, pg8::StaticOrder, true, true>(C.lds + RING_OFF, g, S, E);
    } SEAM(12);

    if (IN(13)) { p11_rows(C); }
#undef IN
#undef SEAM
}

#ifndef MK_SPLIT
#define MK_SPLIT 0
#endif
extern "C" void kernel_launch(void* const* d_in, const int* in_sizes, int n_in, void* d_out, int out_size, void* d_ws, size_t ws_size, hipStream_t stream) {
    static int grid = 0;
    if (grid == 0) {
        if (n_in != 24 || (size_t)out_size != OUT_TOTAL || ws_size < WS_END) { fprintf(stderr, "kernel_launch: unexpected problem (n_in %d, out %d, ws %zu)\n", n_in, out_size, ws_size); grid = -1; return; }
        int dev = 0, cus = 0, per_cu = 0;
        if (hipGetDevice(&dev) != hipSuccess || hipDeviceGetAttribute(&cus, hipDeviceAttributeMultiprocessorCount, dev) != hipSuccess) { grid = -1; return; }
        if (hipFuncSetAttribute((const void*)mk_fwd, hipFuncAttributeMaxDynamicSharedMemorySize, LDS_BYTES) != hipSuccess) { fprintf(stderr, "kernel_launch: hipFuncSetAttribute failed\n"); grid = -1; return; }
        if (hipOccupancyMaxActiveBlocksPerMultiprocessor(&per_cu, (const void*)mk_fwd, NTHR, LDS_BYTES) != hipSuccess || per_cu < 1) fprintf(stderr, "kernel_launch: occupancy query reports %d\n", per_cu);
        (void)hipGetLastError();
        grid = cus;
    }
    if (grid < 0) return;
    if (hipMemsetAsync((char*)d_ws + WS_CTL, 0, CTL_ZERO_BYTES, stream) != hipSuccess) return;
    Args a{};
    for (int i = 0; i < 24; ++i) a.in[i] = d_in[i];
    a.out = (float*)d_out; a.ws = (unsigned char*)d_ws;
#if MK_SPLIT
    for (int p = 0; p < NPHASE; ++p) { a.ph_lo = p; a.ph_hi = p + 1; hipLaunchKernelGGL(mk_fwd, dim3(grid), dim3(NTHR), LDS_BYTES, stream, a); }
#else
    a.ph_lo = 0; a.ph_hi = NPHASE;
    hipLaunchKernelGGL(mk_fwd, dim3(grid), dim3(NTHR), LDS_BYTES, stream, a);
#endif
    const hipError_t le = hipPeekAtLastError();
    if (le != hipSuccess) fprintf(stderr, "kernel_launch: launch failed: %s\n", hipGetErrorName(le));
}
```

```cpp
#include <hip/hip_runtime.h>
#include <cstdio>
#include <cstdint>
namespace pg8 {
#define PG8_LAS __attribute__((address_space(3)))
typedef unsigned short bf16_t;
typedef short bf16x8 __attribute__((ext_vector_type(8)));
typedef float f32x4 __attribute__((ext_vector_type(4)));
typedef unsigned u32x4 __attribute__((ext_vector_type(4)));
constexpr int BM = 256, BK = 64, HALF = 128, HTB = HALF * BK * 2  , STAGE_BYTES = 8 * HTB, NXCD = 8, WGM = 8;

__host__ __device__ __forceinline__ int lds_byte(int r, int c) { const int st = (r >> 4) * 2 + (c >> 5), rr = r & 15, cc = c & 31, ob = rr * 64 + cc * 2; return st * 1024 + (ob ^ (((ob >> 9) & 1) << 5)); }
__host__ __device__ __forceinline__ void stage_rc(int b, int& R, int& C) { const int st = b / 1024, sb = b % 1024, swz = sb ^ (((sb >> 9) & 1) << 5); R = (st >> 1) * 16 + swz / 64; C = (st & 1) * 32 + (swz % 64) / 2; }
__host__ __device__ __forceinline__ int perm32(int rho) { const int n = rho >> 4, i = rho & 15; return 8 * (i >> 2) + 4 * n + (i & 3); }

struct Unit { int pm, pn; };
struct Gemm { const bf16_t* A; const bf16_t* Bt; int M, N, K; };

struct StaticOrder {
    int nM, nN, nwg, G, c;
    __host__ __device__ void init(int M, int N, int G_, int c_) { nM = M / BM; nN = N / BM; nwg = nM * nN; G = G_; c = c_; }
    __host__ __device__ bool next(int i, Unit& u) const {
        const long L = (long)i * G + c; if (L >= nwg) return false;
        int wgid = (int)L; { const int q = nwg / NXCD, r = nwg % NXCD, xcd = wgid % NXCD, off = wgid / NXCD; wgid = (xcd < r ? xcd * (q + 1) : r * (q + 1) + (xcd - r) * q) + off; }
        const int nig = WGM * nN, gid = wgid / nig, fm = gid * WGM, gsz = (nM - fm) < WGM ? (nM - fm) : WGM;
        u.pm = fm + ((wgid % nig) % gsz); u.pn = (wgid % nig) / gsz; return true;
    }
    __device__ __forceinline__ void a_ready(const Unit&) const {}
    __device__ __forceinline__ void done(const Unit&) const {}
};

__device__ __forceinline__ unsigned cvt_pk_bf16(float lo, float hi) { unsigned r; asm volatile("v_cvt_pk_bf16_f32 %0, %1, %2" : "=v"(r) : "v"(lo), "v"(hi)); return r; }
typedef float f32x2 __attribute__((ext_vector_type(2)));

template <class F> struct EpiGen {
    static constexpr bool PERM = true, AFTER_DRAIN = false;
    F f;
    __device__ __forceinline__ void operator()(const f32x4 (&acc)[2][2][4][2], const Unit& u, int wr, int wc, int fr, int fq) const {
        const int row0 = u.pm * BM + wr * 64 + fr, col0 = u.pn * BM + wc * 32 + 8 * fq;
#pragma unroll
        for (int ai = 0; ai < 2; ++ai)
#pragma unroll
            for (int m = 0; m < 4; ++m)
#pragma unroll
                for (int bj = 0; bj < 2; ++bj)
                    f.store8(row0 + ai * HALF + m * 16, col0 + bj * HALF, u.pn, acc[ai][bj][m][0], acc[ai][bj][m][1]);
    }
};
template <class Epi, class Sched, bool ALIGN_EPI = false, bool SP2 = false>
__device__ __forceinline__ void gemm_phase(PG8_LAS unsigned char* lds, const Gemm g, const Sched& S, const Epi& E) {
    const int tid = threadIdx.x, wid = __builtin_amdgcn_readfirstlane(tid >> 6), lane = tid & 63, wr = wid >> 2, wc = wid & 3, fr = lane & 15, fq = lane >> 4;
    const int K = g.K, nt = K / BK;
    unsigned voffA[2], voffB[2];
#pragma unroll
    for (int i = 0; i < 2; ++i) { int R, C; stage_rc(tid * 16 + i * 8192, R, C); const int Rb = Epi::PERM ? ((R & ~31) + perm32(R & 31)) : R;
        voffA[i] = (unsigned)(R * K + C) * 2u; voffB[i] = (unsigned)(Rb * K + C) * 2u; }
    const size_t kstep = (size_t)(BK * 2);
    const size_t hstep = (size_t)HALF * K * 2;
    const size_t tstep = 2 * hstep;
    const unsigned ldsw = (unsigned)wid * 1024u;
    const int aoff = lds_byte(wr * 64 + fr, fq * 8), boff = lds_byte(wc * 32 + fr, fq * 8);
#define PG8_SA(b, h) (((b) * 2 + (h)) * HTB)
#define PG8_SB(b, h) ((4 + (b) * 2 + (h)) * HTB)
#define PG8_STAGE(bufoff, gbase, voff) do { _Pragma("unroll") for (int _i = 0; _i < 2; ++_i) \
        __builtin_amdgcn_global_load_lds((const unsigned*)((const char*)(gbase) + (voff)[_i]), (PG8_LAS unsigned*)(lds + (bufoff) + ldsw + _i * 8192), 16, 0, 0); } while (0)
#define PG8_LDA(dst, b, h) do { _Pragma("unroll") for (int m = 0; m < 4; ++m) _Pragma("unroll") for (int k = 0; k < 2; ++k) dst[m][k] = *(const PG8_LAS bf16x8*)(lds + PG8_SA(b, h) + aoff + m * 2048 + k * 1024); } while (0)
#define PG8_LDB(dst, b, h) do { _Pragma("unroll") for (int n = 0; n < 2; ++n) _Pragma("unroll") for (int k = 0; k < 2; ++k) dst[n][k] = *(const PG8_LAS bf16x8*)(lds + PG8_SB(b, h) + boff + n * 2048 + k * 1024); } while (0)
#define PG8_MMA(ai, bj, At, Bt) do { __builtin_amdgcn_s_setprio(1); _Pragma("unroll") for (int m = 0; m < 4; ++m) _Pragma("unroll") for (int n = 0; n < 2; ++n) _Pragma("unroll") for (int k = 0; k < 2; ++k) \
        acc[ai][bj][m][n] = __builtin_amdgcn_mfma_f32_16x16x32_bf16(Bt[n][k], At[m][k], acc[ai][bj][m][n], 0, 0, 0); __builtin_amdgcn_s_setprio(0); } while (0)
#define PG8_WAIT_V(n) asm volatile("s_waitcnt vmcnt(" #n ")" ::: "memory")
#define PG8_WAIT_L(n) asm volatile("s_waitcnt lgkmcnt(" #n ")" ::: "memory")
#define PG8_BAR __builtin_amdgcn_s_barrier()
#define PG8_SCHED __builtin_amdgcn_sched_barrier(0)
    Unit cur, nxt; int ui = 0;
    if (!S.next(0, cur)) return;
    f32x4 acc[2][2][4][2];
#pragma unroll
    for (int a = 0; a < 2; ++a)
#pragma unroll
        for (int b = 0; b < 2; ++b)
#pragma unroll
            for (int m = 0; m < 4; ++m)
#pragma unroll
                for (int n = 0; n < 2; ++n) acc[a][b][m][n] = (f32x4){0.f, 0.f, 0.f, 0.f};
    bf16x8 At[4][2], B0[2][2], B1[2][2];
    const char* cA = (const char*)g.A + (size_t)cur.pm * tstep; const char* cB = (const char*)g.Bt + (size_t)cur.pn * tstep;
    S.a_ready(cur);
    if constexpr (SP2) {
        PG8_STAGE(PG8_SB(0, 0), cB, voffB); PG8_STAGE(PG8_SB(0, 1), cB + hstep, voffB); PG8_STAGE(PG8_SA(0, 0), cA, voffA); PG8_STAGE(PG8_SA(0, 1), cA + hstep, voffA);
        if (wr == 1) PG8_BAR;
        PG8_WAIT_V(2); PG8_BAR;
        PG8_STAGE(PG8_SB(1, 0), cB + kstep, voffB); PG8_STAGE(PG8_SA(1, 0), cA + kstep, voffA); PG8_STAGE(PG8_SB(1, 1), cB + hstep + kstep, voffB);
        PG8_WAIT_V(6); PG8_BAR;
    } else {
        PG8_STAGE(PG8_SB(0, 0), cB, voffB); PG8_STAGE(PG8_SA(0, 0), cA, voffA); PG8_STAGE(PG8_SB(0, 1), cB + hstep, voffB); PG8_STAGE(PG8_SA(0, 1), cA + hstep, voffA);
        if (wr == 1) PG8_BAR;
        PG8_WAIT_V(4); PG8_BAR;
        PG8_STAGE(PG8_SB(1, 0), cB + kstep, voffB); PG8_STAGE(PG8_SA(1, 0), cA + kstep, voffA); PG8_STAGE(PG8_SB(1, 1), cB + hstep + kstep, voffB);
        PG8_WAIT_V(6); PG8_BAR;
    }
    for (;;) {
        const bool has_next = S.next(ui + 1, nxt);
        const char* nA = has_next ? (const char*)g.A + (size_t)nxt.pm * tstep : cA; const char* nB = has_next ? (const char*)g.Bt + (size_t)nxt.pn * tstep : cB;
        for (int t = 0; t < nt; t += 2) {
            const bool last = (t == nt - 2);
            const char* a1 = cA + (size_t)(t + 1) * kstep;
            const char* a2 = last ? nA : cA + (size_t)(t + 2) * kstep; const char* b2 = last ? nB : cB + (size_t)(t + 2) * kstep;
            const char* a3 = a2 + kstep; const char* b3 = b2 + kstep;
            if (last && has_next) S.a_ready(nxt);
            if constexpr (SP2) {
            PG8_LDB(B0, 0, 0); PG8_LDB(B1, 0, 1); PG8_SCHED; PG8_LDA(At, 0, 0); PG8_STAGE(PG8_SA(1, 1), a1 + hstep, voffA);
            PG8_WAIT_V(8); PG8_WAIT_L(0); PG8_BAR; PG8_MMA(0, 0, At, B0); PG8_MMA(0, 1, At, B1); PG8_BAR; PG8_SCHED;
            PG8_LDA(At, 0, 1); PG8_STAGE(PG8_SB(0, 0), b2, voffB); PG8_STAGE(PG8_SB(0, 1), b2 + hstep, voffB); PG8_STAGE(PG8_SA(0, 0), a2, voffA);
            PG8_WAIT_V(8); PG8_WAIT_L(0); PG8_BAR; PG8_MMA(1, 0, At, B0); PG8_MMA(1, 1, At, B1); PG8_BAR; PG8_SCHED;
            PG8_LDB(B0, 1, 0); PG8_LDB(B1, 1, 1); PG8_SCHED; PG8_LDA(At, 1, 0); PG8_STAGE(PG8_SA(0, 1), a2 + hstep, voffA);
            PG8_WAIT_V(8); PG8_WAIT_L(0); PG8_BAR; PG8_MMA(0, 0, At, B0); PG8_MMA(0, 1, At, B1); PG8_BAR; PG8_SCHED;
            PG8_LDA(At, 1, 1); PG8_STAGE(PG8_SB(1, 0), b3, voffB); PG8_STAGE(PG8_SB(1, 1), b3 + hstep, voffB); PG8_STAGE(PG8_SA(1, 0), a3, voffA);
            PG8_WAIT_V(8); PG8_WAIT_L(0); PG8_BAR; PG8_MMA(1, 0, At, B0); PG8_MMA(1, 1, At, B1); PG8_BAR; PG8_SCHED;
            } else {
            PG8_LDB(B0, 0, 0); PG8_SCHED; PG8_LDA(At, 0, 0); PG8_STAGE(PG8_SA(1, 1), a1 + hstep, voffA);
            PG8_WAIT_L(8); PG8_BAR; PG8_WAIT_L(0); PG8_MMA(0, 0, At, B0); PG8_BAR; PG8_SCHED;
            PG8_LDB(B1, 0, 1); PG8_STAGE(PG8_SB(0, 0), b2, voffB);
            PG8_BAR; PG8_WAIT_L(0); PG8_MMA(0, 1, At, B1); PG8_BAR;
            PG8_LDA(At, 0, 1); PG8_STAGE(PG8_SA(0, 0), a2, voffA);
            PG8_BAR; PG8_WAIT_L(0); PG8_MMA(1, 0, At, B0); PG8_BAR; PG8_SCHED;
            PG8_STAGE(PG8_SB(0, 1), b2 + hstep, voffB);
            PG8_WAIT_V(6); PG8_BAR; PG8_MMA(1, 1, At, B1); PG8_BAR;
            PG8_LDB(B0, 1, 0); PG8_SCHED; PG8_LDA(At, 1, 0); PG8_STAGE(PG8_SA(0, 1), a2 + hstep, voffA);
            PG8_WAIT_L(8); PG8_BAR; PG8_WAIT_L(0); PG8_MMA(0, 0, At, B0); PG8_BAR; PG8_SCHED;
            PG8_LDB(B1, 1, 1); PG8_STAGE(PG8_SB(1, 0), b3, voffB);
            PG8_BAR; PG8_WAIT_L(0); PG8_MMA(0, 1, At, B1); PG8_BAR;
            PG8_LDA(At, 1, 1); PG8_STAGE(PG8_SA(1, 0), a3, voffA);
            PG8_BAR; PG8_WAIT_L(0); PG8_MMA(1, 0, At, B0); PG8_BAR; PG8_SCHED;
            PG8_STAGE(PG8_SB(1, 1), b3 + hstep, voffB);
            PG8_WAIT_V(6); PG8_BAR; PG8_MMA(1, 1, At, B1); PG8_BAR;
            }
        }
        if constexpr (ALIGN_EPI) { if (wr == 0) PG8_BAR; }
        if constexpr (!Epi::AFTER_DRAIN) { E(acc, cur, wr, wc, fr, fq); S.done(cur); }
        if (!has_next) break;
#pragma unroll
        for (int a = 0; a < 2; ++a)
#pragma unroll
            for (int b = 0; b < 2; ++b)
#pragma unroll
                for (int m = 0; m < 4; ++m)
#pragma unroll
                    for (int n = 0; n < 2; ++n) acc[a][b][m][n] = (f32x4){0.f, 0.f, 0.f, 0.f};
        cur = nxt; cA = nA; cB = nB; ++ui;
        if constexpr (ALIGN_EPI) { if (wr == 1) PG8_BAR; }
    }
    PG8_WAIT_V(0);
    if constexpr (!ALIGN_EPI) { if (wr == 0) PG8_BAR; }
    PG8_BAR;
    if constexpr (Epi::AFTER_DRAIN) { E.fused(acc, cur, wr, wc, fr, fq, lds, wid, lane); S.done(cur); }
#undef PG8_SA
#undef PG8_SB
#undef PG8_STAGE
#undef PG8_LDA
#undef PG8_LDB
#undef PG8_MMA
#undef PG8_WAIT_V
#undef PG8_WAIT_L
#undef PG8_BAR
#undef PG8_SCHED
}
}
#define GAS __attribute__((address_space(1)))
#define LAS __attribute__((address_space(3)))
typedef unsigned short bf16;
typedef unsigned v4u __attribute__((ext_vector_type(4)));
typedef float f32x4 __attribute__((ext_vector_type(4)));
typedef short bf16x8 __attribute__((ext_vector_type(8)));
typedef GAS unsigned gu32;
typedef GAS unsigned long long gu64;
#define RLX_AGENT __ATOMIC_RELAXED, __HIP_MEMORY_SCOPE_AGENT
#define LDS_WAIT() asm volatile("s_waitcnt lgkmcnt(0)" ::: "memory")
#define VM_WAIT() asm volatile("s_waitcnt vmcnt(0)" ::: "memory")
__device__ __forceinline__ unsigned long long rt() { return __builtin_amdgcn_s_memrealtime(); }
__device__ __forceinline__ unsigned f2bf(float f) { unsigned u = __builtin_bit_cast(unsigned, f); return (u + 0x7fffu + ((u >> 16) & 1u)) >> 16; }
__device__ __forceinline__ unsigned pk2(float lo, float hi) { return f2bf(lo) | (f2bf(hi) << 16); }

#define XB_TMO      128
#define XB_XCNT(j)  (256  + 64 * (j))
#define XB_XSUB(j)  (1280 + 64 * (j))
#define XB_XGEN(j)  (2304 + 64 * (j))
#define XB_TOP      3328
#define XB_TOPGEN   3392
#define XCD_BAR_WORDS 3456
#define XB_SPIN_CAP (1u << 18)

__device__ __forceinline__ unsigned xb_ld(unsigned* p)              { return __hip_atomic_load(p, __ATOMIC_RELAXED, __HIP_MEMORY_SCOPE_AGENT); }
__device__ __forceinline__ unsigned xb_add(unsigned* p, unsigned v) { return __hip_atomic_fetch_add(p, v, __ATOMIC_RELAXED, __HIP_MEMORY_SCOPE_AGENT); }
__device__ __forceinline__ unsigned xb_xcc_id() { return (unsigned)__builtin_amdgcn_s_getreg((3 << 11) | 20) & 0xFu; }
#define XB_SPIN(cond, bar) do { unsigned _sp = 0; while (cond) { __builtin_amdgcn_s_sleep(1); \
    if ((++_sp & 255u) == 0u) { if (xb_ld(&(bar)[XB_TMO])) break; if (_sp > XB_SPIN_CAP) { atomicAdd(&(bar)[XB_TMO], 1u); break; } } } } while (0)

struct XcdBarrier {
    unsigned* bar; unsigned x;
    volatile LAS unsigned* st;
};

__device__ __forceinline__ XcdBarrier xcd_barrier_post(unsigned* bar, volatile LAS unsigned* st) {
    XcdBarrier b; b.bar = bar; b.x = xb_xcc_id(); b.st = st;
    if (threadIdx.x == 0) (void)xb_add(&bar[XB_XCNT(b.x)], 1u);
    return b;
}
__device__ __forceinline__ void xcd_barrier_complete(unsigned* bar, unsigned x, unsigned& nloc, unsigned& nx) {
    const unsigned G = gridDim.x * gridDim.y * gridDim.z;
    unsigned sum, cnt, mine, sp = 0u;
    for (;;) {
        sum = 0u; cnt = 0u; mine = 0u;
#pragma unroll
        for (unsigned j = 0; j < 16; ++j) { const unsigned c = xb_ld(&bar[XB_XCNT(j)]); sum += c; cnt += (c > 0u) ? 1u : 0u; mine = (j == x) ? c : mine; }
        if (sum == G) break;
        __builtin_amdgcn_s_sleep(1);
        if ((++sp & 255u) == 0u) { if (xb_ld(&bar[XB_TMO])) break; if (sp > XB_SPIN_CAP) { atomicAdd(&bar[XB_TMO], 1u); break; } }
    }
    nloc = mine > 0u ? mine : 1u; nx = cnt > 0u ? cnt : 1u;
}

__device__ __forceinline__ void xcd_barrier(const XcdBarrier& b) {
    asm volatile("s_waitcnt vmcnt(0)" ::: "memory");
    __syncthreads();
    if (threadIdx.x == 0) {
        unsigned* bar = b.bar;
        __builtin_amdgcn_s_waitcnt(0);
        unsigned nloc = b.st[0], nx = b.st[1];
        if (nloc == 0u) { xcd_barrier_complete(bar, b.x, nloc, nx); b.st[0] = nloc; b.st[1] = nx; }
        const unsigned old = xb_add(&bar[XB_XSUB(b.x)], 1u);
        const unsigned gen = old / nloc;
        if (old + 1u == (gen + 1u) * nloc) {
            __builtin_amdgcn_fence(__ATOMIC_RELEASE, "agent");
            asm volatile("s_waitcnt vmcnt(0)" ::: "memory");
            const unsigned og = xb_add(&bar[XB_TOP], 1u);
            const unsigned tg = og / nx;
            if (og + 1u == (tg + 1u) * nx) xb_add(&bar[XB_TOPGEN], 1u);
            else XB_SPIN(xb_ld(&bar[XB_TOPGEN]) == tg, bar);
            __builtin_amdgcn_fence(__ATOMIC_ACQUIRE, "agent");
            xb_add(&bar[XB_XGEN(b.x)], 1u);
            asm volatile("s_waitcnt vmcnt(0)" ::: "memory");
        } else {
            XB_SPIN(xb_ld(&bar[XB_XGEN(b.x)]) == gen, bar);
            __builtin_amdgcn_fence(__ATOMIC_ACQUIRE, "agent");
            asm volatile("s_waitcnt vmcnt(0)" ::: "memory");
        }
    }
    __syncthreads();
}

constexpr int NWAVES = 8, NTHR = 512;
constexpr int DM = 1024, SEQ = 8192, NB = 2, MP = NB * SEQ;
constexpr int DB = 32, DS = 8, MS = DB * DS, MT = MP + MS;
constexpr int AH = 8, AD = 64, AW = 512;
constexpr int BH = 4, BK_ = 128, BV = 256, BKW = 512, BVW = 1024, GR = 16;
constexpr int DFF = 2816, DFF2 = 5632;
constexpr int PAST = 8192, PAGE = 128, NPAGES = 64;
constexpr int DIN = 6680, NU = 6912;
constexpr int UC_QA = 0, UC_KA = 512, UC_VA = 1024, UC_QB = 1536, UC_KB = 2048, UC_VB = 2560, UC_RB = 3584, UC_GA = 4608, UC_GB = 5632, UC_FA = 6656, UC_AL = 6664;
constexpr float EPS = 1e-6f;
constexpr float LOG2E = 1.4426950408889634f;
constexpr float C2 = 0.125f * LOG2E;
constexpr float QB_SCALE = 0.08838834764831845f;
constexpr size_t OFF_YP = 0, OFF_YS = (size_t)MP * DM, OFF_KP = OFF_YS + (size_t)MS * DM, OFF_VP = OFF_KP + (size_t)MP * AW, OFF_FP = OFF_VP + (size_t)MP * AW,
                 OFF_GP = OFF_FP + (size_t)MP * AH, OFF_CP = OFF_GP + (size_t)NB * BH * BK_ * BV, OFF_KS = OFF_CP + (size_t)NB * 2 * DFF2, OFF_VS = OFF_KS + (size_t)MS * AW,
                 OFF_FS = OFF_VS + (size_t)MS * AW, OFF_GS = OFF_FS + (size_t)MS * AH, OFF_CS = OFF_GS + (size_t)DB * BH * BK_ * BV, OUT_TOTAL = OFF_CS + (size_t)DB * 2 * DFF2;
static_assert(OUT_TOTAL == 39051264, "output size");

constexpr size_t MiB = 1u << 20;
constexpr size_t WS_CTL = 0, CTL_ZERO_BYTES = 1 * MiB;
constexpr size_t al_(size_t x) { return (x + (MiB - 1)) & ~(MiB - 1); }
constexpr size_t WS_WIN = al_(WS_CTL + CTL_ZERO_BYTES);
constexpr size_t WS_WPA = al_(WS_WIN + (size_t)NU * DM * 2);
constexpr size_t WS_WPB = al_(WS_WPA + (size_t)DM * AW * 2);
constexpr size_t WS_WOUT = al_(WS_WPB + (size_t)DM * BVW * 2);
constexpr size_t WS_WUP = al_(WS_WOUT + (size_t)DM * DM * 2);
constexpr size_t WS_WDN = al_(WS_WUP + (size_t)DFF2 * DM * 2);
constexpr size_t WS_ALOW = al_(WS_WDN + (size_t)DM * DFF * 2);
constexpr size_t WS_FA = al_(WS_ALOW + (size_t)MT * GR * 4);
constexpr size_t WS_CB = al_(WS_FA + (size_t)MT * AH * 4);
constexpr size_t WS_SB = al_(WS_CB + (size_t)NB * AH * SEQ * 4);
constexpr size_t WS_PART = al_(WS_SB + (size_t)DB * AH * PAST * 4);
constexpr size_t WS_XN = al_(WS_PART + (size_t)256 * AH * DS * 68 * 4);
constexpr size_t WS_OA = al_(WS_XN + (size_t)MT * DM * 2);
constexpr size_t WS_OB = al_(WS_OA + (size_t)MT * AW * 2);
constexpr size_t WS_MG = al_(WS_OB + (size_t)MT * BVW * 2);
constexpr size_t WS_XN2 = al_(WS_MG + (size_t)MT * DM * 2);
constexpr size_t WS_ACT = al_(WS_XN2 + (size_t)MT * DM * 2);
constexpr size_t WS_U = al_(WS_ACT + (size_t)MT * DFF * 2);
constexpr size_t WS_UU = al_(WS_U + (size_t)MT * NU * 2);
constexpr size_t WS_OBR = al_(WS_UU + (size_t)MT * DFF2 * 2);
constexpr size_t WS_TA = al_(WS_OBR + (size_t)MT * BVW * 4);
constexpr size_t WS_F1 = al_(WS_TA + (size_t)MT * DM * 4);
constexpr size_t WS_X1 = al_(WS_F1 + (size_t)MT * DM * 4);
constexpr size_t WS_F2 = al_(WS_X1 + (size_t)MT * DM * 4);
constexpr size_t WS_LS = al_(WS_F2 + (size_t)MT * DM * 4);
constexpr size_t WS_DSC = al_(WS_LS + (size_t)256 * BK_ * BV * 4);
constexpr size_t WS_END = al_(WS_DSC + (size_t)256 * BK_ * 4);
static_assert(WS_END < (size_t)2600 * MiB, "workspace");
constexpr int CW_BAR = 4096;
constexpr int PART_STRIDE = 68;

constexpr int RING_OFF = 0, RING_BYTES = 147456;
constexpr int LDSCTL_OFF = RING_BYTES, MISC_OFF = LDSCTL_OFF + 320;
constexpr int LDS_BYTES = 151552;

typedef unsigned short bf16;
typedef unsigned v4u __attribute__((ext_vector_type(4)));
typedef unsigned v2u __attribute__((ext_vector_type(2)));
typedef float f32x4 __attribute__((ext_vector_type(4)));
typedef float f32x16 __attribute__((ext_vector_type(16)));
typedef short bf16x8 __attribute__((ext_vector_type(8)));
typedef short s16x4 __attribute__((ext_vector_type(4)));

__device__ __forceinline__ float bf2f(unsigned short u) { return __uint_as_float((unsigned)u << 16); }
__device__ __forceinline__ float bflo(unsigned u) { return __uint_as_float(u << 16); }
__device__ __forceinline__ float bfhi(unsigned u) { return __uint_as_float(u & 0xffff0000u); }
__device__ __forceinline__ float sigmoidf_(float x) { return 1.f / (1.f + __expf(-x)); }
__device__ __forceinline__ float logsigmoidf_(float x) { return fminf(x, 0.f) - log1pf(expf(-fabsf(x))); }
__device__ __forceinline__ float wave_sum(float v) {
#pragma unroll
    for (int o = 1; o < 64; o <<= 1) v += __shfl_xor(v, o);
    return v;
}

#define KAS __attribute__((address_space(4)))
struct Ctx {
    LAS unsigned char* lds;
    int tid, lane, wave, G, bid;
    const char KAS* ka;
    float* out; unsigned char* ws;
};
struct Args { const void* in[24]; float* out; unsigned char* ws; int ph_lo, ph_hi; };
#define INF(k) (*(const float* const KAS*)(C.ka + 8 * (k)))
enum { I_XP = 0, I_XS, I_CK, I_CV, I_CF, I_SG, I_SC, I_PT, I_GPM, I_WIN, I_BF, I_WA2, I_BA, I_GGLA, I_WPA, I_WPB, I_WOUT, I_GPOM, I_GPF, I_WUP, I_WCONV, I_BCONV, I_WDN, I_GPOF };

__device__ __forceinline__ void transpose_item(const float* W, int ldw, int c0, int ncols, int K, bf16* WT, int r0, LAS float* scr, int item, int lane) {
    const int nblk = (ncols + 31) / 32, kb = item / nblk, nb = item % nblk, k0 = 64 * kb, n0 = 32 * nb;
    const bool cok = (n0 + (lane & 31)) < ncols;
    float tv[32];
#pragma unroll
    for (int i = 0; i < 32; ++i) { const int kk = 2 * i + (lane >> 5); tv[i] = cok ? W[(size_t)(k0 + kk) * ldw + c0 + n0 + (lane & 31)] : 0.f; }
#pragma unroll
    for (int i = 0; i < 32; ++i) { const int kk = 2 * i + (lane >> 5); scr[kk * 33 + (lane & 31)] = tv[i]; }
    LDS_WAIT(); asm volatile("" ::: "memory");
    const int c = lane & 7;
#pragma unroll
    for (int j = 0; j < 4; ++j) { const int n = (lane >> 3) + 8 * j; const LAS float* s = scr + (8 * c) * 33 + n;
        v4u o; o.x = pk2(s[0 * 33], s[1 * 33]); o.y = pk2(s[2 * 33], s[3 * 33]); o.z = pk2(s[4 * 33], s[5 * 33]); o.w = pk2(s[6 * 33], s[7 * 33]);
        if (n0 + n < ncols) *(GAS v4u*)(WT + (size_t)(r0 + n0 + n) * K + k0 + 8 * c) = o; }
    LDS_WAIT(); asm volatile("" ::: "memory");
}
__device__ __forceinline__ void rms_row_to_bf16(const float* xrow, const float* g, bf16* orow, int lane) {
    const GAS f32x4* xr = (const GAS f32x4*)xrow + lane; const GAS f32x4* gr = (const GAS f32x4*)g + lane;
    f32x4 v[4]; float s = 0.f;
#pragma unroll
    for (int j = 0; j < 4; ++j) { v[j] = xr[64 * j]; s += (v[j].x * v[j].x + v[j].y * v[j].y) + (v[j].z * v[j].z + v[j].w * v[j].w); }
    const float r = 1.f / sqrtf(wave_sum(s) * (1.f / DM) + EPS);
    GAS unsigned long long* o8 = (GAS unsigned long long*)orow + lane;
#pragma unroll
    for (int j = 0; j < 4; ++j) { const f32x4 gg = gr[64 * j]; o8[64 * j] = (unsigned long long)pk2(v[j].x * r * gg.x, v[j].y * r * gg.y) | ((unsigned long long)pk2(v[j].z * r * gg.z, v[j].w * r * gg.w) << 32); }
}
struct TSeg { int src, ldw, c0, ncols, K, dst, r0; };
__device__ __forceinline__ void rms_row2_to_bf16(const float* x0, const float* x1, const float* g, bf16* orow, int lane) {
    const GAS f32x4* a = (const GAS f32x4*)x0 + lane; const GAS f32x4* b = (const GAS f32x4*)x1 + lane; const GAS f32x4* gr = (const GAS f32x4*)g + lane;
    f32x4 v[4], w[4]; float s = 0.f, t = 0.f;
#pragma unroll
    for (int j = 0; j < 4; ++j) { v[j] = a[64 * j]; w[j] = b[64 * j]; }
#pragma unroll
    for (int j = 0; j < 4; ++j) { s += (v[j].x * v[j].x + v[j].y * v[j].y) + (v[j].z * v[j].z + v[j].w * v[j].w); t += (w[j].x * w[j].x + w[j].y * w[j].y) + (w[j].z * w[j].z + w[j].w * w[j].w); }
    const float r = 1.f / sqrtf(wave_sum(s) * (1.f / DM) + EPS), q = 1.f / sqrtf(wave_sum(t) * (1.f / DM) + EPS);
    GAS unsigned long long* o8 = (GAS unsigned long long*)orow + lane;
#pragma unroll
    for (int j = 0; j < 4; ++j) { const f32x4 gg = gr[64 * j];
        o8[64 * j] = (unsigned long long)pk2(v[j].x * r * gg.x, v[j].y * r * gg.y) | ((unsigned long long)pk2(v[j].z * r * gg.z, v[j].w * r * gg.w) << 32);
        o8[256 + 64 * j] = (unsigned long long)pk2(w[j].x * q * gg.x, w[j].y * q * gg.y) | ((unsigned long long)pk2(w[j].z * q * gg.z, w[j].w * q * gg.w) << 32); }
}
__device__ __forceinline__ void p0_prologue(Ctx& C) {
    LAS float* scr = (LAS float*)(C.lds + RING_OFF + C.wave * 16384);
    const int gw = C.bid * NWAVES + C.wave, NGW = C.G * NWAVES;
    bf16* Win = (bf16*)(C.ws + WS_WIN);
#define NI(w, K) ((((w) + 31) / 32) * ((K) / 64))
    constexpr int n0 = NI(512, DM), n1 = NI(1024, DM), n2 = NI(8, DM), n3 = NI(16, DM);
    constexpr int T_WIN = 5 * n0 + 4 * n1 + n2 + n3, T_WPA = NI(DM, AW), T_WPB = NI(DM, BVW), T_WOUT = NI(DM, DM), T_WUP = NI(DFF2, DM), T_WDN = NI(DM, DFF);
    constexpr int TOTAL = T_WIN + T_WPA + T_WPB + T_WOUT + T_WUP + T_WDN;
    for (int it0 = gw; it0 < TOTAL; it0 += NGW) {
        int it = it0;
#define SEG(c0, w, r0) if (it < NI(w, DM)) { transpose_item(INF(I_WIN), DIN, (c0), (w), DM, Win, (r0), scr, it, C.lane); continue; } it -= NI(w, DM);
        SEG(0, 512, UC_QA) SEG(512, 512, UC_KA) SEG(1024, 512, UC_VA) SEG(1536, 8, UC_FA) SEG(1544, 512, UC_QB) SEG(2056, 512, UC_KB)
        SEG(2568, 1024, UC_VB) SEG(3592, 16, UC_AL) SEG(3608, 1024, UC_RB) SEG(4632, 1024, UC_GA) SEG(5656, 1024, UC_GB)
#undef SEG
        if (it < T_WPA) { transpose_item(INF(I_WPA), DM, 0, DM, AW, (bf16*)(C.ws + WS_WPA), 0, scr, it, C.lane); continue; } it -= T_WPA;
        if (it < T_WPB) { transpose_item(INF(I_WPB), DM, 0, DM, BVW, (bf16*)(C.ws + WS_WPB), 0, scr, it, C.lane); continue; } it -= T_WPB;
        if (it < T_WOUT) { transpose_item(INF(I_WOUT), DM, 0, DM, DM, (bf16*)(C.ws + WS_WOUT), 0, scr, it, C.lane); continue; } it -= T_WOUT;
        if (it < T_WUP) { transpose_item(INF(I_WUP), DFF2, 0, DFF2, DM, (bf16*)(C.ws + WS_WUP), 0, scr, it, C.lane); continue; } it -= T_WUP;
        transpose_item(INF(I_WDN), DM, 0, DM, DFF, (bf16*)(C.ws + WS_WDN), 0, scr, it, C.lane);
    }
#undef NI
    { const int n16 = (NU - DIN) * DM * 2 / 16; GAS v4u* z = (GAS v4u*)(Win + (size_t)DIN * DM);
      for (int i = C.bid * NTHR + C.tid; i < n16; i += C.G * NTHR) z[i] = (v4u){0u, 0u, 0u, 0u}; }
    bf16* XN = (bf16*)(C.ws + WS_XN);
    for (int m = (NGW - 1 - gw) * 2; m < MT; m += NGW * 2) {
        const float* xr0 = m < MP ? INF(I_XP) + (size_t)m * DM : INF(I_XS) + (size_t)(m - MP) * DM; const float* xr1 = xr0 + DM;
        rms_row2_to_bf16(xr0, xr1, INF(I_GPM), XN + (size_t)m * DM, C.lane);
    }
}

__device__ __forceinline__ v4u pack8(f32x4 a, f32x4 b, float s) { v4u w; w.x = pg8::cvt_pk_bf16(a[0] * s, a[1] * s); w.y = pg8::cvt_pk_bf16(a[2] * s, a[3] * s); w.z = pg8::cvt_pk_bf16(b[0] * s, b[1] * s); w.w = pg8::cvt_pk_bf16(b[2] * s, b[3] * s); return w; }
struct StInProj {
    bf16* U; float* out; float* alow; float* fa;
    __device__ __forceinline__ void store8(int row, int col, int pn, f32x4 a, f32x4 b) const {
        if (pn == 26) {
            if (col == UC_FA) {
                float* dst = fa + (size_t)row * AH;
                *(f32x4*)dst = a; *(f32x4*)(dst + 4) = b;
            } else if (col == UC_AL || col == UC_AL + 8) {
                float* dst = alow + (size_t)row * GR + (col - UC_AL);
                *(f32x4*)dst = a; *(f32x4*)(dst + 4) = b;
            }
            return;
        }
        const float sc = pn < 2 ? C2 : ((pn == 6 || pn == 7) ? QB_SCALE : 1.f);
        *(v4u*)(U + (size_t)row * NU + col) = pack8(a, b, sc);
        if (pn >= 2 && pn < 6) {
            float* dst;
            if (pn < 4) dst = (row < MP ? out + OFF_KP + (size_t)row * AW : out + OFF_KS + (size_t)(row - MP) * AW) + (col - UC_KA);
            else        dst = (row < MP ? out + OFF_VP + (size_t)row * AW : out + OFF_VS + (size_t)(row - MP) * AW) + (col - UC_VA);
            *(f32x4*)dst = a; *(f32x4*)(dst + 4) = b;
        }
    }
};
struct StProjA {
    const bf16* U; float* TA;
    __device__ __forceinline__ void store8(int row, int col, int, f32x4 a, f32x4 b) const {
        const v4u g = *(const v4u*)(U + (size_t)row * NU + UC_GA + col);
        f32x4 x, y;
        x[0] = a[0] * sigmoidf_(bflo(g.x)); x[1] = a[1] * sigmoidf_(bfhi(g.x)); x[2] = a[2] * sigmoidf_(bflo(g.y)); x[3] = a[3] * sigmoidf_(bfhi(g.y));
        y[0] = b[0] * sigmoidf_(bflo(g.z)); y[1] = b[1] * sigmoidf_(bfhi(g.z)); y[2] = b[2] * sigmoidf_(bflo(g.w)); y[3] = b[3] * sigmoidf_(bfhi(g.w));
        float* dst = TA + (size_t)row * DM + col; *(f32x4*)dst = x; *(f32x4*)(dst + 4) = y;
    }
};
struct StProjB {
    const bf16* U; const float* TA; bf16* MG;
    __device__ __forceinline__ void store8(int row, int col, int, f32x4 a, f32x4 b) const {
        const v4u g = *(const v4u*)(U + (size_t)row * NU + UC_GB + col);
        const float* src = TA + (size_t)row * DM + col; const f32x4 t0 = *(const f32x4*)src, t1 = *(const f32x4*)(src + 4);
        f32x4 x, y;
        x[0] = t0[0] + a[0] * sigmoidf_(bflo(g.x)); x[1] = t0[1] + a[1] * sigmoidf_(bfhi(g.x)); x[2] = t0[2] + a[2] * sigmoidf_(bflo(g.y)); x[3] = t0[3] + a[3] * sigmoidf_(bfhi(g.y));
        y[0] = t1[0] + b[0] * sigmoidf_(bflo(g.z)); y[1] = t1[1] + b[1] * sigmoidf_(bfhi(g.z)); y[2] = t1[2] + b[2] * sigmoidf_(bflo(g.w)); y[3] = t1[3] + b[3] * sigmoidf_(bfhi(g.w));
        *(v4u*)(MG + (size_t)row * DM + col) = pack8(x, y, 1.f);
    }
};
struct StF32 {
    float* O;
    __device__ __forceinline__ void store8(int row, int col, int, f32x4 a, f32x4 b) const { float* dst = O + (size_t)row * DM + col; *(f32x4*)dst = a; *(f32x4*)(dst + 4) = b; }
};
struct StUp {
    bf16* UU; float* out;
    __device__ __forceinline__ void store8(int row, int col, int, f32x4 a, f32x4 b) const {
        *(v4u*)(UU + (size_t)row * DFF2 + col) = pack8(a, b, 1.f);
        float* dst = nullptr;
        if (row < MP) { const int t = row & (SEQ - 1); if (t >= SEQ - 2) dst = out + OFF_CP + ((size_t)(row >> 13) * 2 + (t - (SEQ - 2))) * DFF2 + col; }
        else { const int r = row - MP, t = r & 7; if (t >= 6) dst = out + OFF_CS + ((size_t)(r >> 3) * 2 + (t - 6)) * DFF2 + col; }
        if (dst) { *(f32x4*)dst = a; *(f32x4*)(dst + 4) = b; }
    }
};

__device__ __forceinline__ void p2_scans(Ctx& C) {
    LAS float* red = (LAS float*)(C.lds + RING_OFF);
    const int* pt = (const int*)INF(I_PT);
    const int nunits = NB * AH + DB * AH;
    for (int u = C.bid; u < nunits; u += C.G) {
        float v[16]; float tot = 0.f;
        if (u < NB * AH) {
            const int b = u >> 3, h = u & 7; const float* src = (const float*)(C.ws + WS_FA) + ((size_t)b * SEQ + C.tid * 16) * AH + h;
            float* lo_ = C.out + OFF_FP + ((size_t)b * SEQ + C.tid * 16) * AH + h; const float bfh = INF(I_BF)[h];
#pragma unroll
            for (int i = 0; i < 16; ++i) { const float lf = logsigmoidf_(src[(size_t)i * AH] + bfh); lo_[(size_t)i * AH] = lf; tot += lf; v[i] = tot; }
        } else {
            const int db = (u - NB * AH) >> 3, h = u & 7; const int p0 = C.tid * 16; const int pg = pt[db * NPAGES + (p0 >> 7)];
            const float* src = INF(I_CF) + ((size_t)pg * PAGE + (p0 & 127)) * AH + h;
#pragma unroll
            for (int i = 15; i >= 0; --i) { v[i] = tot; tot += src[(size_t)i * AH]; }
        }
        __syncthreads();
        red[C.tid] = tot;
        __syncthreads();
        float pre = 0.f;
        if (u < NB * AH) { for (int i = 0; i < C.tid; ++i) pre += red[i]; }
        else { for (int i = NTHR - 1; i > C.tid; --i) pre += red[i]; }
        float* dst = u < NB * AH ? (float*)(C.ws + WS_CB) + (size_t)u * SEQ + C.tid * 16 : (float*)(C.ws + WS_SB) + (size_t)(u - NB * AH) * PAST + C.tid * 16;
        const float sgn = u < NB * AH ? -LOG2E : LOG2E;
#pragma unroll
        for (int i = 0; i < 16; i += 4) *(f32x4*)(dst + i) = (f32x4){(v[i] + pre) * sgn, (v[i + 1] + pre) * sgn, (v[i + 2] + pre) * sgn, (v[i + 3] + pre) * sgn};
    }
    if (C.bid == C.G - 1) for (int e = C.tid; e < MS * AH; e += NTHR) C.out[OFF_FS + e] = logsigmoidf_(((const float*)(C.ws + WS_FA))[(size_t)MP * AH + e] + INF(I_BF)[e & 7]);
    __syncthreads();
}


namespace att {
using s16x4_ = s16x4;
constexpr int NW = 8, QBLK = 32, QB = 256, KVBLK = 64;
constexpr int NSLOT = 3, SLOTB = 8192;
constexpr int LDS_K = 0, LDS_V = NSLOT * SLOTB, LDS_WS = 2 * NSLOT * SLOTB, LDS_OST = LDS_WS + NW * 64 * 4, LDS_BYTES_ = LDS_OST + NW * 4096;
constexpr int LDS_BIAS = 86016, LDS_TOTAL = LDS_BIAS + SEQ * 4;
static_assert(LDS_TOTAL <= RING_BYTES, "attention LDS");
__device__ __forceinline__ int crow(int r, int hi) { return (r & 3) + 8 * (r >> 2) + 4 * hi; }
#define SBAR() __builtin_amdgcn_sched_barrier(0)
__device__ __forceinline__ void cmask(f32x16& p0, f32x16& p1, int jb, int qrel, int hi) {
    const float NEG = -INFINITY; int kb = 64 * jb + 4 * hi;
#pragma unroll
    for (int r = 0; r < 16; ++r) { int kv = kb + (r & 3) + 8 * (r >> 2); if (kv > qrel) p0[r] = NEG; if (kv + 32 > qrel) p1[r] = NEG; }
}
__device__ __forceinline__ void glds16(const void* gsrc, unsigned lds_dst) { unsigned keep;
    asm volatile("s_mov_b32 %0, m0\n\ts_mov_b32 m0, %2\n\ts_nop 0\n\tglobal_load_lds_dwordx4 %1, off\n\ts_mov_b32 m0, %0" : "=&s"(keep) : "v"(gsrc), "s"(lds_dst) : "memory"); }
typedef float f32x2_t __attribute__((ext_vector_type(2))); typedef __bf16 bf16x2_t __attribute__((ext_vector_type(2)));
__device__ __forceinline__ unsigned cvtpk_s(float lo, float hi) { f32x2_t v = {lo, hi}; bf16x2_t b = __builtin_convertvector(v, bf16x2_t); return __builtin_bit_cast(unsigned, b); }
#define WAIT_BAR(N) asm volatile("s_waitcnt vmcnt(" #N ") lgkmcnt(0)\n\ts_barrier" ::: "memory")
typedef __attribute__((address_space(3))) const char* lds_cptr;
typedef short v4i16_t __attribute__((ext_vector_type(4)));
__device__ __forceinline__ void kload8(bf16x8* kf, lds_cptr kp) {
    kf[0] = *(const LAS bf16x8*)(kp);        kf[1] = *(const LAS bf16x8*)(kp + 512);
    kf[2] = *(const LAS bf16x8*)(kp + 2048); kf[3] = *(const LAS bf16x8*)(kp + 2560);
    kf[4] = *(const LAS bf16x8*)(kp + 4096); kf[5] = *(const LAS bf16x8*)(kp + 4608);
    kf[6] = *(const LAS bf16x8*)(kp + 6144); kf[7] = *(const LAS bf16x8*)(kp + 6656);
}
__device__ __forceinline__ void kload2(bf16x8* kf, lds_cptr kp, int j) { kf[2 * j] = *(const LAS bf16x8*)(kp + j * 2048); kf[2 * j + 1] = *(const LAS bf16x8*)(kp + j * 2048 + 512); }
__device__ __forceinline__ s16x4 vtr(lds_cptr p) { return __builtin_bit_cast(s16x4, __builtin_amdgcn_ds_read_tr16_b64_v4i16((LAS v4i16_t*)p)); }
#define MX3(a, b, c) __builtin_fmaxf(__builtin_fmaxf((a), (b)), (c))
__device__ __forceinline__ float rowmax(const f32x16& p0, const f32x16& p1) {
    float a = MX3(p0[0], p0[1], p1[0]), b = MX3(p0[2], p0[3], p1[1]); a = MX3(a, p1[2], p1[3]);
#pragma unroll
    for (int r = 4; r < 16; r += 4) { a = MX3(a, p0[r], p0[r + 1]); b = MX3(b, p0[r + 2], p0[r + 3]); a = MX3(a, p1[r], p1[r + 1]); b = MX3(b, p1[r + 2], p1[r + 3]); }
    float m = __builtin_fmaxf(a, b); auto rr = __builtin_amdgcn_permlane32_swap(__float_as_uint(m), __float_as_uint(m), false, false);
    return __builtin_fmaxf(__uint_as_float(rr[0]), __uint_as_float(rr[1]));
}
__device__ __forceinline__ void pv(f32x16* o, int vb, bf16x8 pa0, bf16x8 pa1, bf16x8 pa2, bf16x8 pa3) {
#pragma unroll
    for (int d0 = 0; d0 < 2; ++d0) { s16x4 lo[4], hi[4];
#pragma unroll
        for (int ks = 0; ks < 4; ++ks) {
            asm volatile("ds_read_b64_tr_b16 %0,%1 offset:%c2" : "=&v"(lo[ks]) : "v"(vb), "i"(d0 * 4096 + ks * 1024) : "memory");
            asm volatile("ds_read_b64_tr_b16 %0,%1 offset:%c2" : "=&v"(hi[ks]) : "v"(vb), "i"(d0 * 4096 + ks * 1024 + 512) : "memory"); }
        asm volatile("s_waitcnt lgkmcnt(0)" ::: "memory"); SBAR();
#define PK(k) (bf16x8){lo[k][0], lo[k][1], lo[k][2], lo[k][3], hi[k][0], hi[k][1], hi[k][2], hi[k][3]}
        o[d0] = __builtin_amdgcn_mfma_f32_32x32x16_bf16(pa0, PK(0), o[d0], 0, 0, 0);
        o[d0] = __builtin_amdgcn_mfma_f32_32x32x16_bf16(pa1, PK(1), o[d0], 0, 0, 0);
        o[d0] = __builtin_amdgcn_mfma_f32_32x32x16_bf16(pa2, PK(2), o[d0], 0, 0, 0);
        o[d0] = __builtin_amdgcn_mfma_f32_32x32x16_bf16(pa3, PK(3), o[d0], 0, 0, 0);
#undef PK
    }
}
__device__ __forceinline__ void bias_ld(f32x16& c0, f32x16& c1, const LAS float* bl, int t, int hi, int g0, int g1) {
#pragma unroll
    for (int g = 0; g < 4; ++g) { if (g < g0 || g >= g1) continue;
        const f32x4 a = *(const LAS f32x4*)(bl + t * 64 + 8 * g + 4 * hi), b = *(const LAS f32x4*)(bl + t * 64 + 32 + 8 * g + 4 * hi);
        c0[4 * g] = a[0]; c0[4 * g + 1] = a[1]; c0[4 * g + 2] = a[2]; c0[4 * g + 3] = a[3]; c1[4 * g] = b[0]; c1[4 * g + 1] = b[1]; c1[4 * g + 2] = b[2]; c1[4 * g + 3] = b[3]; }
}
template <int THRL> __device__ __forceinline__ void attn_unit(int b, int h, int qb, const bf16* U, const float* CB, bf16* OA, LAS unsigned char* shmL) {
    char* shm = (char*)shmL;
    const int tid = threadIdx.x, lane = tid & 63, r32 = lane & 31, hi = lane >> 5; const int wid = __builtin_amdgcn_readfirstlane(tid >> 6);
    const long rowbase = (long)b * SEQ; const int q0 = qb * QB;
    const bf16* Qw = U + (rowbase + q0 + wid * QBLK) * NU + UC_QA + h * 64;
    const bf16* Kh = U + rowbase * NU + UC_KA + h * 64; const bf16* Vh = U + rowbase * NU + UC_VA + h * 64;
    const unsigned lds0 = (unsigned)(uintptr_t)shm;
    LAS float* wsf = (LAS float*)(shmL + LDS_WS) + wid * 64;
    const LAS float* bl = (const LAS float*)(shmL + LDS_BIAS);
    const int NT = (q0 + QB) / KVBLK;
    { const float* CBh = CB + (size_t)(b * AH + h) * SEQ; LAS float* blw = (LAS float*)(shmL + LDS_BIAS);
      for (int e = tid * 4; e < NT * 64; e += NTHR * 4) *(LAS f32x4*)(blw + e) = *(const f32x4*)(CBh + e);
      asm volatile("s_waitcnt vmcnt(0)" ::: "memory"); }
    const bf16* ksrc = Kh + (long)lane * NU + wid * 8;
    const bf16* vsrc = Vh + (long)(16 * (wid & 3) + (lane >> 2)) * NU + (wid >> 2) * 32 + (lane & 3) * 8;
    const unsigned kdst = lds0 + LDS_K + wid * 1024, vdst = lds0 + LDS_V + wid * 1024;
#define DMA_K(t, slot) glds16(ksrc + (long)(t) * KVBLK * NU, (unsigned)__builtin_amdgcn_readfirstlane(kdst + (slot)))
#define DMA_V(t, slot) glds16(vsrc + (long)(t) * KVBLK * NU, (unsigned)__builtin_amdgcn_readfirstlane(vdst + (slot)))
    const int vb0 = (int)(lds0 + LDS_V) + ((lane >> 4) & 1) * 32 + (lane & 3) * 8 + (4 * hi + ((lane & 15) >> 2)) * 64;
    bf16x8 kf[8];
    const lds_cptr shm3 = (lds_cptr)shmL; const lds_cptr kp0 = shm3 + LDS_K + hi * 1024 + r32 * 16; const lds_cptr vp0 = shm3 + LDS_V + ((lane >> 4) & 1) * 32 + (lane & 3) * 8 + (4 * hi + ((lane & 15) >> 2)) * 64;
    DMA_K(0, 0); DMA_V(0, 0); DMA_K(1, SLOTB);
    bf16x8 qr[4];
#pragma unroll
    for (int d0 = 0; d0 < 4; ++d0) qr[d0] = *reinterpret_cast<const bf16x8*>(&Qw[(long)r32 * NU + d0 * 16 + hi * 8]);
    float mhat = 0.f, l_reg = 0.f; f32x16 o[2]; o[0] = f32x16{}; o[1] = f32x16{};
    const int qrel = wid * QBLK + r32;
#define CMASK(P0, P1, t) do { int jb_ = (t) - (NT - 4); if (jb_ >= 0) cmask(P0, P1, jb_, qrel, hi); } while (0)
    bool resc = false;
#define START(P0, P1) do { const float rm = rowmax(P0, P1); resc = false; \
    { const float dl = rm; mhat = mhat + dl; \
      _Pragma("unroll") for (int r = 0; r < 16; ++r) { P0[r] = P0[r] - dl; P1[r] = P1[r] - dl; } } \
    _Pragma("unroll") for (int r = 0; r < 16; ++r) P0[r] = __builtin_amdgcn_exp2f(P0[r]); } while (0)
#define RESC() do { if (resc) { asm volatile("s_waitcnt lgkmcnt(0)" ::: "memory"); \
      _Pragma("unroll") for (int d_ = 0; d_ < 2; ++d_) _Pragma("unroll") for (int r = 0; r < 16; ++r) o[d_][r] *= wsf[crow(r, hi)]; } } while (0)
    f32x16 pA0, pA1, pB0, pB1;
    int sl_prev = 0, sl_cur = 0, sl_next = SLOTB;
#define ROT() do { sl_prev = sl_cur; sl_cur = sl_next; sl_next = (sl_next == (NSLOT - 1) * SLOTB) ? 0 : sl_next + SLOTB; } while (0)
    DMA_K(2, 2 * SLOTB);
    WAIT_BAR(3);
    bias_ld(pA0, pA1, bl, 0, hi, 0, 4);
    { const lds_cptr kb = kp0;
#pragma unroll
      for (int d0 = 0; d0 < 4; ++d0) { const bf16x8 b0 = *(const LAS bf16x8*)(kb + d0 * 2048), b1 = *(const LAS bf16x8*)(kb + d0 * 2048 + 512);
          pA0 = __builtin_amdgcn_mfma_f32_32x32x16_bf16(b0, qr[d0], pA0, 0, 0, 0); pA1 = __builtin_amdgcn_mfma_f32_32x32x16_bf16(b1, qr[d0], pA1, 0, 0, 0); } }
    CMASK(pA0, pA1, 0);
    START(pA0, pA1);
    _Pragma("unroll") for (int r = 0; r < 16; ++r) pA1[r] = __builtin_amdgcn_exp2f(pA1[r]);
    WAIT_BAR(0);
    DMA_K(3, 0); DMA_V(1, SLOTB);
    ROT();
    kload8(kf, kp0 + sl_cur);
    bias_ld(pB0, pB1, bl, 1, hi, 0, 4);
    WAIT_BAR(2);
    s16x4 vlo[8], vhi[8]; v4u pw0, pw1, pw2, pw3;
#define PKW(P, B) cvtpk_s(P[B], P[B + 1])
#define PAF(k) __builtin_bit_cast(bf16x8, pw##k)
#define VFR(i) (bf16x8){vlo[i][0], vlo[i][1], vlo[i][2], vlo[i][3], vhi[i][0], vhi[i][1], vhi[i][2], vhi[i][3]}
#define PIN(x) asm volatile("" : "+v"(x))
#define GAPA(MF, A0, A1, A2, A3, W0, W1, PW) do { MF; sacc += A0; sacc += A1; sacc += A2; sacc += A3; PIN(sacc); W0; W1; PIN(PW); SBAR(); } while (0)
#define EX(v) __builtin_amdgcn_exp2f(v)
#define GAPB(MF, X, B) do { MF; X[B] = EX(X[B]); X[B + 1] = EX(X[B + 1]); X[B + 2] = EX(X[B + 2]); X[B + 3] = EX(X[B + 3]); PIN(X); SBAR(); } while (0)
#define VRD(i) do { vlo[i] = vtr(vp_ + (((i) >> 2) * 4096 + ((i) & 3) * 1024)); vhi[i] = vtr(vp_ + (((i) >> 2) * 4096 + ((i) & 3) * 1024 + 512)); } while (0)
#define KRD(G, j) do { if (G) { kload2(kf, kp0 + sl_next, j); SBAR(); } } while (0)
#define BRD(G, P0, P1, t, g0, g1) do { if (G) { bias_ld(P0, P1, bl, (t) + 1, hi, g0, g1); SBAR(); } } while (0)
#define STEP(C0, C1, P0, P1, t, GK, GV, GL) do { SBAR(); \
    const lds_cptr vp_ = vp0 + sl_prev; \
    { const float nm_ = -mhat; _Pragma("unroll") for (int r = 0; r < 16; ++r) { C0[r] += nm_; C1[r] += nm_; } } \
    VRD(0); SBAR(); float sacc = (P0[0] + P0[1]); \
    GAPA(C0 = __builtin_amdgcn_mfma_f32_32x32x16_bf16(kf[0], qr[0], C0, 0, 0, 0), P0[2], P0[3], P0[4], P0[5],     pw0[0] = PKW(P0, 0), pw0[1] = PKW(P0, 2), pw0); \
    VRD(4); SBAR(); GAPA(C1 = __builtin_amdgcn_mfma_f32_32x32x16_bf16(kf[1], qr[0], C1, 0, 0, 0), P0[6], P0[7], P0[8], P0[9],     pw0[2] = PKW(P0, 4), pw0[3] = PKW(P0, 6), pw0); \
    VRD(1); SBAR(); GAPA(C0 = __builtin_amdgcn_mfma_f32_32x32x16_bf16(kf[2], qr[1], C0, 0, 0, 0),   P0[10], P0[11], P0[12], P0[13], pw1[0] = PKW(P0, 8), pw1[1] = PKW(P0, 10), pw1); \
    VRD(5); SBAR(); GAPA(C1 = __builtin_amdgcn_mfma_f32_32x32x16_bf16(kf[3], qr[1], C1, 0, 0, 0),   P0[14], P0[15], P1[0], P1[1],   pw1[2] = PKW(P0, 12), pw1[3] = PKW(P0, 14), pw1); \
    VRD(2); SBAR(); GAPA(C0 = __builtin_amdgcn_mfma_f32_32x32x16_bf16(kf[4], qr[2], C0, 0, 0, 0),   P1[2], P1[3], P1[4], P1[5],     pw2[0] = PKW(P1, 0), pw2[1] = PKW(P1, 2), pw2); \
    VRD(6); SBAR(); GAPA(C1 = __builtin_amdgcn_mfma_f32_32x32x16_bf16(kf[5], qr[2], C1, 0, 0, 0),   P1[6], P1[7], P1[8], P1[9],     pw2[2] = PKW(P1, 4), pw2[3] = PKW(P1, 6), pw2); \
    VRD(3); SBAR(); GAPA(C0 = __builtin_amdgcn_mfma_f32_32x32x16_bf16(kf[6], qr[3], C0, 0, 0, 0),   P1[10], P1[11], P1[12], P1[13], pw3[0] = PKW(P1, 8), pw3[1] = PKW(P1, 10), pw3); \
    VRD(7); SBAR(); GAPA(C1 = __builtin_amdgcn_mfma_f32_32x32x16_bf16(kf[7], qr[3], C1, 0, 0, 0),   P1[14], P1[15], 0.f, 0.f,       pw3[2] = PKW(P1, 12), pw3[3] = PKW(P1, 14), pw3); \
    l_reg += sacc; \
    if (GK) { DMA_K((t) + 3, sl_cur); } if (GV) { DMA_V((t) + 1, sl_next); } \
    CMASK(C0, C1, t); \
    { float a = MX3(C0[0], C0[1], C1[0]), b = MX3(C0[2], C0[3], C1[1]); a = MX3(a, C1[2], C1[3]); \
      _Pragma("unroll") for (int r = 4; r < 16; r += 4) { a = MX3(a, C0[r], C0[r + 1]); b = MX3(b, C0[r + 2], C0[r + 3]); a = MX3(a, C1[r], C1[r + 1]); b = MX3(b, C1[r + 2], C1[r + 3]); } \
      float rm = __builtin_fmaxf(a, b); { auto rr = __builtin_amdgcn_permlane32_swap(__float_as_uint(rm), __float_as_uint(rm), false, false); rm = __builtin_fmaxf(__uint_as_float(rr[0]), __uint_as_float(rr[1])); } \
      resc = false; \
      if (__builtin_expect(__any(rm > (float)THRL), 0)) { const float dl = __builtin_fmaxf(rm, 0.f); mhat += dl; \
        _Pragma("unroll") for (int r = 0; r < 16; ++r) { C0[r] -= dl; C1[r] -= dl; } \
        const float f = __builtin_amdgcn_exp2f(-dl); l_reg *= f; if (hi == 0) wsf[r32] = f; resc = true; } } \
    SBAR(); \
    GAPB(o[0] = __builtin_amdgcn_mfma_f32_32x32x16_bf16(PAF(0), VFR(0), o[0], 0, 0, 0), C0, 0); \
    BRD(GL, P0, P1, t, 0, 1); GAPB(o[1] = __builtin_amdgcn_mfma_f32_32x32x16_bf16(PAF(0), VFR(4), o[1], 0, 0, 0), C0, 4); \
    KRD(GL, 0); GAPB(o[0] = __builtin_amdgcn_mfma_f32_32x32x16_bf16(PAF(1), VFR(1), o[0], 0, 0, 0), C0, 8); \
    KRD(GL, 1); GAPB(o[1] = __builtin_amdgcn_mfma_f32_32x32x16_bf16(PAF(1), VFR(5), o[1], 0, 0, 0), C0, 12); \
    KRD(GL, 2); GAPB(o[0] = __builtin_amdgcn_mfma_f32_32x32x16_bf16(PAF(2), VFR(2), o[0], 0, 0, 0), C1, 0); \
    KRD(GL, 3); GAPB(o[1] = __builtin_amdgcn_mfma_f32_32x32x16_bf16(PAF(2), VFR(6), o[1], 0, 0, 0), C1, 4); \
    BRD(GL, P0, P1, t, 1, 2); GAPB(o[0] = __builtin_amdgcn_mfma_f32_32x32x16_bf16(PAF(3), VFR(3), o[0], 0, 0, 0), C1, 8); \
    BRD(GL, P0, P1, t, 2, 4); GAPB(o[1] = __builtin_amdgcn_mfma_f32_32x32x16_bf16(PAF(3), VFR(7), o[1], 0, 0, 0), C1, 12); \
    } while (0)
    int t = 1;
#undef CMASK
#define CMASK(P0, P1, t) do { } while (0)
    for (; t + 5 < NT; t += 2) {
        STEP(pB0, pB1, pA0, pA1, t, true, true, true);     WAIT_BAR(2); RESC(); ROT();
        STEP(pA0, pA1, pB0, pB1, t + 1, true, true, true); WAIT_BAR(2); RESC(); ROT();
    }
#undef CMASK
#define CMASK(P0, P1, t) do { int jb_ = (t) - (NT - 4); if (jb_ >= 0) cmask(P0, P1, jb_, qrel, hi); } while (0)
#define ENDW(tt) do { if ((tt) + 3 < NT) { WAIT_BAR(2); } else if ((tt) + 2 < NT) { WAIT_BAR(1); } else { WAIT_BAR(0); } } while (0)
    for (; t + 1 < NT; t += 2) {
        STEP(pB0, pB1, pA0, pA1, t, (t + 3 < NT), (t + 1 < NT), (t + 1 < NT));     ENDW(t);     RESC(); ROT();
        STEP(pA0, pA1, pB0, pB1, t + 1, (t + 4 < NT), (t + 2 < NT), (t + 2 < NT)); ENDW(t + 1); RESC(); ROT();
    }
    STEP(pB0, pB1, pA0, pA1, NT - 1, false, false, false); RESC();
    { float sacc = pB0[0] + pB0[1]; _Pragma("unroll") for (int r = 2; r < 16; ++r) sacc += pB0[r]; _Pragma("unroll") for (int r = 0; r < 16; ++r) sacc += pB1[r]; l_reg += sacc;
      pw0 = (v4u){PKW(pB0, 0), PKW(pB0, 2), PKW(pB0, 4), PKW(pB0, 6)}; pw1 = (v4u){PKW(pB0, 8), PKW(pB0, 10), PKW(pB0, 12), PKW(pB0, 14)}; pw2 = (v4u){PKW(pB1, 0), PKW(pB1, 2), PKW(pB1, 4), PKW(pB1, 6)}; pw3 = (v4u){PKW(pB1, 8), PKW(pB1, 10), PKW(pB1, 12), PKW(pB1, 14)};
      SBAR(); pv(o, vb0 + sl_cur, PAF(0), PAF(1), PAF(2), PAF(3)); }
#undef PKW
#undef PAF
#undef VFR
#undef PIN
#undef GAPA
#undef GAPB
#undef EX
#undef VRD
#undef KRD
#undef BRD
#undef STEP
#undef ENDW
    { auto rr = __builtin_amdgcn_permlane32_swap(__float_as_uint(l_reg), __float_as_uint(l_reg), false, false); l_reg = __uint_as_float(rr[0]) + __uint_as_float(rr[1]); }
    if (hi == 0) wsf[32 + r32] = l_reg; asm volatile("s_waitcnt lgkmcnt(0)" ::: "memory");
    float rli[16];
#pragma unroll
    for (int r = 0; r < 16; ++r) rli[r] = __builtin_amdgcn_rcpf(wsf[32 + crow(r, hi)]);
    bf16* Ow = OA + (rowbase + q0 + wid * QBLK) * AW + h * 64;
    { LAS bf16* stg = (LAS bf16*)(shmL + LDS_OST) + wid * 2048;
#pragma unroll
      for (int r = 0; r < 16; ++r) { const int orow = crow(r, hi);
#pragma unroll
          for (int d0 = 0; d0 < 2; ++d0) stg[orow * 64 + d0 * 32 + r32] = (bf16)(cvtpk_s(o[d0][r] * rli[r], 0.f) & 0xffffu); }
      asm volatile("s_waitcnt lgkmcnt(0)" ::: "memory");
#pragma unroll
      for (int i = 0; i < 4; ++i) { const int row = i * 8 + (lane >> 3), ch = lane & 7; const v4u v = *(const LAS v4u*)(stg + row * 64 + ch * 8); *(v4u*)(Ow + (long)row * AW + ch * 8) = v; } }
    asm volatile("s_waitcnt vmcnt(0) lgkmcnt(0)\n\ts_barrier" ::: "memory");
#undef DMA_K
#undef DMA_V
#undef CMASK
#undef START
#undef RESC
#undef ROT
}
#undef SBAR
#undef WAIT_BAR
#undef MX3
}

__device__ __forceinline__ void sattn_unit(Ctx& C, int db, int rg) {
    const int lane = C.lane, h = C.wave, q = lane & 15, fq = lane >> 4;
    const bf16* U = (const bf16*)(C.ws + WS_U);
    const int* pt = (const int*)INF(I_PT);
    const float* SBh = (const float*)(C.ws + WS_SB) + (size_t)(db * AH + h) * PAST + rg * 1024;
    float qf[4][4];
    { const bf16* qrow = U + (size_t)(MP + db * DS + (q & 7)) * NU + UC_QA + h * 64;
#pragma unroll
      for (int m = 0; m < 4; ++m) { const v2u w = *(const v2u*)(qrow + (4 * m + fq) * 4);
          qf[m][0] = q < 8 ? bflo(w.x) : 0.f; qf[m][1] = q < 8 ? bfhi(w.x) : 0.f; qf[m][2] = q < 8 ? bflo(w.y) : 0.f; qf[m][3] = q < 8 ? bfhi(w.y) : 0.f; } }
    float mrun = -INFINITY, lsum = 0.f; f32x4 o[4];
#pragma unroll
    for (int j = 0; j < 4; ++j) o[j] = (f32x4){0.f, 0.f, 0.f, 0.f};
    for (int blk = 0; blk < 64; ++blk) {
        const int pg = pt[db * NPAGES + rg * 8 + (blk >> 3)]; const size_t tok0 = (size_t)pg * PAGE + (blk & 7) * 16;
        const float* Kb = INF(I_CK) + tok0 * AW + h * 64; const float* Vb = INF(I_CV) + tok0 * AW + h * 64;
        f32x4 kk[4], vv[4];
#pragma unroll
        for (int m = 0; m < 4; ++m) kk[m] = *(const f32x4*)(Kb + (size_t)q * AW + (4 * m + fq) * 4);
#pragma unroll
        for (int r4 = 0; r4 < 4; ++r4) vv[r4] = *(const f32x4*)(Vb + (size_t)(4 * fq + r4) * AW + q * 4);
        f32x4 s = *(const f32x4*)(SBh + blk * 16 + 4 * fq);
#pragma unroll
        for (int m = 0; m < 4; ++m)
#pragma unroll
            for (int j = 0; j < 4; ++j) s = __builtin_amdgcn_mfma_f32_16x16x4f32(kk[m][j], qf[m][j], s, 0, 0, 0);
        float rm = fmaxf(fmaxf(s[0], s[1]), fmaxf(s[2], s[3]));
        rm = fmaxf(rm, __shfl_xor(rm, 16)); rm = fmaxf(rm, __shfl_xor(rm, 32));
        const float mn = fmaxf(mrun, rm); const float f = __builtin_amdgcn_exp2f(mrun - mn); mrun = mn;
        f32x4 p;
#pragma unroll
        for (int i = 0; i < 4; ++i) p[i] = __builtin_amdgcn_exp2f(s[i] - mn);
        lsum = lsum * f + (p[0] + p[1]) + (p[2] + p[3]);
#pragma unroll
        for (int j = 0; j < 4; ++j) o[j] = o[j] * f;
#pragma unroll
        for (int r4 = 0; r4 < 4; ++r4)
#pragma unroll
            for (int j = 0; j < 4; ++j) o[j] = __builtin_amdgcn_mfma_f32_16x16x4f32(vv[r4][j], p[r4], o[j], 0, 0, 0);
    }
    lsum += __shfl_xor(lsum, 16); lsum += __shfl_xor(lsum, 32);
    if (q < 8) {
        float* dst = (float*)(C.ws + WS_PART) + ((size_t)((db * 8 + rg) * AH + h) * DS + q) * PART_STRIDE;
        if (fq == 0) { dst[0] = mrun; dst[1] = lsum; }
#pragma unroll
        for (int j = 0; j < 4; ++j)
#pragma unroll
            for (int r = 0; r < 4; ++r) dst[4 + 4 * (4 * fq + r) + j] = o[j][r];
    }
}
__device__ __forceinline__ void sattn_combine(Ctx& C) {
    const bf16* U = (const bf16*)(C.ws + WS_U); bf16* OA = (bf16*)(C.ws + WS_OA);
    const int gw = C.bid * NWAVES + C.wave, NGW = C.G * NWAVES, d = C.lane;
    for (int it = gw; it < DB * AH * DS; it += NGW) {
        const int db = it >> 6, h = (it >> 3) & 7, q = it & 7;
        const float qd = bf2f(U[(size_t)(MP + db * DS + q) * NU + UC_QA + h * 64 + d]);
        float sn[8]; float cn = 0.f; float M = -INFINITY;
#pragma unroll
        for (int j = 0; j < 8; ++j) {
            cn += C.out[OFF_FS + (size_t)(db * DS + j) * AH + h];
            const float kd = C.out[OFF_KS + (size_t)(db * DS + j) * AW + h * 64 + d];
            const float s = wave_sum(qd * kd) - cn * LOG2E;
            sn[j] = j <= q ? s : -INFINITY; M = fmaxf(M, sn[j]);
        }
        float pm[8], pl[8];
#pragma unroll
        for (int r = 0; r < 8; ++r) { const float* src = (const float*)(C.ws + WS_PART) + ((size_t)((db * 8 + r) * AH + h) * DS + q) * PART_STRIDE; pm[r] = src[0]; pl[r] = src[1]; M = fmaxf(M, pm[r]); }
        float L = 0.f, O = 0.f;
#pragma unroll
        for (int r = 0; r < 8; ++r) { const float* src = (const float*)(C.ws + WS_PART) + ((size_t)((db * 8 + r) * AH + h) * DS + q) * PART_STRIDE; const float w = __builtin_amdgcn_exp2f(pm[r] - M); L += pl[r] * w; O += src[4 + d] * w; }
#pragma unroll
        for (int j = 0; j < 8; ++j) { const float w = __builtin_amdgcn_exp2f(sn[j] - M); L += w; O += w * C.out[OFF_VS + (size_t)(db * DS + j) * AW + h * 64 + d]; }
        OA[(size_t)(MP + db * DS + q) * AW + h * 64 + d] = (bf16)f2bf(O / L);
    }
}


namespace gla {
constexpr int QSTR = 136, TSTR = 72;
constexpr int L_ALB = 0, L_W2 = 4096, L_BA = 12288, L_PRE = 12800, L_D = 14848, L_QS = 15360, L_KS = 32768, L_KLT = 50176, L_VT = 68608, L_BC = 105472, L_END = 138240;
__device__ __forceinline__ int perm16(int x) { return (x & ~15) | (((x >> 2) & 1) << 3) | (((x >> 3) & 1) << 2) | (x & 3); }
__device__ __forceinline__ int crow(int r, int hi) { return (r & 3) + 8 * (r >> 2) + 4 * hi; }
typedef float f32x2_t __attribute__((ext_vector_type(2))); typedef __bf16 bf16x2_t __attribute__((ext_vector_type(2)));
__device__ __forceinline__ unsigned cvtv(float lo, float hi) { f32x2_t v = {lo, hi}; bf16x2_t b = __builtin_convertvector(v, bf16x2_t); return __builtin_bit_cast(unsigned, b); }
__device__ __forceinline__ bf16x8 packacc(const f32x16& a, int s) {
    v4u w;
    if (s == 0) { w.x = cvtv(a[0], a[1]); w.y = cvtv(a[2], a[3]); w.z = cvtv(a[4], a[5]); w.w = cvtv(a[6], a[7]); }
    else        { w.x = cvtv(a[8], a[9]); w.y = cvtv(a[10], a[11]); w.z = cvtv(a[12], a[13]); w.w = cvtv(a[14], a[15]); }
    return __builtin_bit_cast(bf16x8, w);
}
__device__ __forceinline__ void load_head(Ctx& C, int h) {
    LAS float* W2 = (LAS float*)(C.lds + L_W2); LAS float* BA = (LAS float*)(C.lds + L_BA);
    __syncthreads();
    for (int e = C.tid; e < 2048; e += NTHR) W2[e] = INF(I_WA2)[(e >> 7) * BKW + h * 128 + (e & 127)];
    if (C.tid < 128) BA[C.tid] = INF(I_BA)[h * 128 + C.tid];
}
template <bool NEED_QK> __device__ __forceinline__ void stage_chunk(Ctx& C, int row_c0, int nvalid, int h) {
    const bf16* U = (const bf16*)(C.ws + WS_U); const float* alow = (const float*)(C.ws + WS_ALOW);
    LAS float* ALB = (LAS float*)(C.lds + L_ALB); LAS float* W2 = (LAS float*)(C.lds + L_W2); LAS float* BA = (LAS float*)(C.lds + L_BA);
    LAS float* PRE = (LAS float*)(C.lds + L_PRE); LAS float* Dv = (LAS float*)(C.lds + L_D); LAS float* BC = (LAS float*)(C.lds + L_BC);
    LAS bf16* QS = (LAS bf16*)(C.lds + L_QS); LAS bf16* KS = (LAS bf16*)(C.lds + L_KS); LAS bf16* KLT = (LAS bf16*)(C.lds + L_KLT); LAS bf16* VT = (LAS bf16*)(C.lds + L_VT);
    const int tid = C.tid, i = tid & 127, tq = tid >> 7;
    __syncthreads();
#pragma unroll
    for (int n = 0; n < 2; ++n) { const int e = tid + NTHR * n; ALB[e] = (e >> 4) < nvalid ? alow[(size_t)row_c0 * GR + e] : 0.f; }
#pragma unroll
    for (int n = 0; n < 4; ++n) { const int e = tid + NTHR * n, t = e & 63, vg = e >> 6;
        v4u w = (v4u){0u, 0u, 0u, 0u};
        if (t < nvalid) w = *(const v4u*)(U + (size_t)(row_c0 + t) * NU + UC_VB + h * 256 + vg * 8);
        LAS bf16* d = VT + (vg * 8) * TSTR + perm16(t);
        d[0] = (bf16)(w.x & 0xffffu); d[TSTR] = (bf16)(w.x >> 16); d[2 * TSTR] = (bf16)(w.y & 0xffffu); d[3 * TSTR] = (bf16)(w.y >> 16);
        d[4 * TSTR] = (bf16)(w.z & 0xffffu); d[5 * TSTR] = (bf16)(w.z >> 16); d[6 * TSTR] = (bf16)(w.w & 0xffffu); d[7 * TSTR] = (bf16)(w.w >> 16); }
    __syncthreads();
    {
        float w2[16];
#pragma unroll
        for (int r = 0; r < 16; ++r) w2[r] = W2[r * 128 + i];
        const float ba = BA[i]; float run = 0.f;
#pragma unroll 4
        for (int tt = 0; tt < 16; ++tt) { const int t = 16 * tq + tt; float x = ba;
            const f32x4 a0 = *(const LAS f32x4*)(ALB + t * 16), a1 = *(const LAS f32x4*)(ALB + t * 16 + 4), a2 = *(const LAS f32x4*)(ALB + t * 16 + 8), a3 = *(const LAS f32x4*)(ALB + t * 16 + 12);
            x += a0[0] * w2[0] + a0[1] * w2[1] + a0[2] * w2[2] + a0[3] * w2[3]; x += a1[0] * w2[4] + a1[1] * w2[5] + a1[2] * w2[6] + a1[3] * w2[7];
            x += a2[0] * w2[8] + a2[1] * w2[9] + a2[2] * w2[10] + a2[3] * w2[11]; x += a3[0] * w2[12] + a3[1] * w2[13] + a3[2] * w2[14] + a3[3] * w2[15];
            const float la = (fminf(x, 0.f) - __logf(1.f + __expf(-fabsf(x)))) * (1.f / 16.f);
            run += (t < nvalid) ? la : 0.f; BC[t * 128 + i] = run; }
        PRE[tq * 128 + i] = run;
    }
    __syncthreads();
    {
        const float p0 = PRE[i], p1 = PRE[128 + i], p2 = PRE[256 + i], p3 = PRE[384 + i];
        const float tot = (p0 + p1) + (p2 + p3);
        if (tq == 0) Dv[i] = __expf(tot);
        const int pi = perm16(i);
#pragma unroll 4
        for (int n = 0; n < 16; ++n) { const int t = tq + 4 * n; const int q4 = n >> 2;
            const float pre = q4 == 0 ? 0.f : (q4 == 1 ? p0 : (q4 == 2 ? p0 + p1 : p0 + p1 + p2));
            const float B = BC[t * 128 + i] + pre;
            const size_t ro = (size_t)(row_c0 + t) * NU;
            const float kv = t < nvalid ? bf2f(U[ro + UC_KB + h * 128 + i]) : 0.f;
            KLT[i * TSTR + perm16(t)] = (bf16)f2bf(kv * __expf(tot - B));
            if (NEED_QK) { const float qv = t < nvalid ? bf2f(U[ro + UC_QB + h * 128 + i]) : 0.f; const float e1 = __expf(B);
                QS[t * QSTR + pi] = (bf16)f2bf(qv * e1); KS[t * QSTR + pi] = (bf16)f2bf(kv * __expf(-B)); } }
    }
    __syncthreads();
}
template <bool OUT, bool UPD> __device__ __forceinline__ void mma_chunk(Ctx& C, f32x16 (&acc)[4], int row_c0, int nvalid, int h) {
    const int lane = C.lane, w = C.wave, r32 = lane & 31, hi = lane >> 5;
    const LAS bf16* QS = (const LAS bf16*)(C.lds + L_QS); const LAS bf16* KS = (const LAS bf16*)(C.lds + L_KS);
    const LAS bf16* KLT = (const LAS bf16*)(C.lds + L_KLT); const LAS bf16* VT = (const LAS bf16*)(C.lds + L_VT); const LAS float* Dv = (const LAS float*)(C.lds + L_D);
    bf16x8 vt[4];
#pragma unroll
    for (int ks = 0; ks < 4; ++ks) vt[ks] = *(const LAS bf16x8*)(VT + (32 * w + r32) * TSTR + 16 * ks + 8 * hi);
    if (OUT) {
        char* OBRb = (char*)((float*)(C.ws + WS_OBR) + (size_t)row_c0 * BVW + h * 256 + 32 * w);
        const unsigned ovoff = (unsigned)((4 * hi) * BVW + r32) * 4u;
        f32x16 o0 = f32x16{}, o1 = f32x16{};
#pragma unroll
        for (int rt = 0; rt < 4; ++rt)
#pragma unroll
            for (int s = 0; s < 2; ++s) { const bf16x8 bfr = packacc(acc[rt], s);
                const bf16x8 a0 = *(const LAS bf16x8*)(QS + r32 * QSTR + 32 * rt + 16 * s + 8 * hi), a1 = *(const LAS bf16x8*)(QS + (32 + r32) * QSTR + 32 * rt + 16 * s + 8 * hi);
                o0 = __builtin_amdgcn_mfma_f32_32x32x16_bf16(a0, bfr, o0, 0, 0, 0); o1 = __builtin_amdgcn_mfma_f32_32x32x16_bf16(a1, bfr, o1, 0, 0, 0); }
        __builtin_amdgcn_sched_barrier(0);
        {
            f32x16 X = f32x16{};
#pragma unroll
            for (int kk = 0; kk < 8; ++kk) { const bf16x8 k0 = *(const LAS bf16x8*)(KS + r32 * QSTR + 16 * kk + 8 * hi), q0 = *(const LAS bf16x8*)(QS + r32 * QSTR + 16 * kk + 8 * hi);
                X = __builtin_amdgcn_mfma_f32_32x32x16_bf16(k0, q0, X, 0, 0, 0); }
#pragma unroll
            for (int r = 0; r < 16; ++r) { if (crow(r, hi) > r32) X[r] = 0.f; }
            o0 = __builtin_amdgcn_mfma_f32_32x32x16_bf16(packacc(X, 0), vt[0], o0, 0, 0, 0); o0 = __builtin_amdgcn_mfma_f32_32x32x16_bf16(packacc(X, 1), vt[1], o0, 0, 0, 0);
#pragma unroll
            for (int r = 0; r < 16; ++r) { const int tu = (r & 3) + 8 * (r >> 2); if (tu + 4 * hi < nvalid) *(float*)(OBRb + (size_t)tu * BVW * 4 + ovoff) = o0[r]; }
        }
        __builtin_amdgcn_sched_barrier(0);
        if (nvalid > 32) {
            f32x16 X01 = f32x16{}, X11 = f32x16{};
#pragma unroll
            for (int kk = 0; kk < 8; ++kk) {
                const bf16x8 k0 = *(const LAS bf16x8*)(KS + r32 * QSTR + 16 * kk + 8 * hi), k1 = *(const LAS bf16x8*)(KS + (32 + r32) * QSTR + 16 * kk + 8 * hi);
                const bf16x8 q1 = *(const LAS bf16x8*)(QS + (32 + r32) * QSTR + 16 * kk + 8 * hi);
                X01 = __builtin_amdgcn_mfma_f32_32x32x16_bf16(k0, q1, X01, 0, 0, 0); X11 = __builtin_amdgcn_mfma_f32_32x32x16_bf16(k1, q1, X11, 0, 0, 0); }
#pragma unroll
            for (int r = 0; r < 16; ++r) { if (crow(r, hi) > r32) X11[r] = 0.f; }
            o1 = __builtin_amdgcn_mfma_f32_32x32x16_bf16(packacc(X01, 0), vt[0], o1, 0, 0, 0); o1 = __builtin_amdgcn_mfma_f32_32x32x16_bf16(packacc(X01, 1), vt[1], o1, 0, 0, 0);
            o1 = __builtin_amdgcn_mfma_f32_32x32x16_bf16(packacc(X11, 0), vt[2], o1, 0, 0, 0); o1 = __builtin_amdgcn_mfma_f32_32x32x16_bf16(packacc(X11, 1), vt[3], o1, 0, 0, 0);
#pragma unroll
            for (int r = 0; r < 16; ++r) { const int tu = 32 + (r & 3) + 8 * (r >> 2); if (tu + 4 * hi < nvalid) *(float*)(OBRb + (size_t)tu * BVW * 4 + ovoff) = o1[r]; }
        }
    }
    __builtin_amdgcn_sched_barrier(0);
    if (UPD) {
#pragma unroll
        for (int rt = 0; rt < 4; ++rt) {
            __builtin_amdgcn_sched_barrier(0);
#pragma unroll
            for (int r = 0; r < 16; ++r) acc[rt][r] *= Dv[32 * rt + crow(r, hi)];
#pragma unroll
            for (int ks = 0; ks < 4; ++ks) { const bf16x8 a = *(const LAS bf16x8*)(KLT + (32 * rt + r32) * TSTR + 16 * ks + 8 * hi); acc[rt] = __builtin_amdgcn_mfma_f32_32x32x16_bf16(a, vt[ks], acc[rt], 0, 0, 0); }
        }
    }
}
__device__ __forceinline__ void load_state(f32x16 (&acc)[4], const float* S, int w, int r32, int hi) {
    const unsigned voff = (unsigned)((4 * hi) * BV + 32 * w + r32) * 4u;
#pragma unroll
    for (int rt = 0; rt < 4; ++rt) {
#pragma unroll
        for (int g = 0; g < 4; ++g) { const char* sb = (const char*)S + (size_t)(32 * rt + 8 * g) * BV * 4;
#pragma unroll
            for (int j = 0; j < 4; ++j) acc[rt][4 * g + j] = *(const float*)(sb + voff + j * BV * 4); }
        asm volatile("" ::: "memory");
    }
}
__device__ __forceinline__ void store_state(const f32x16 (&acc)[4], float* S, int w, int r32, int hi) {
    const unsigned voff = (unsigned)((4 * hi) * BV + 32 * w + r32) * 4u;
#pragma unroll
    for (int rt = 0; rt < 4; ++rt) {
#pragma unroll
        for (int g = 0; g < 4; ++g) { char* sb = (char*)S + (size_t)(32 * rt + 8 * g) * BV * 4;
#pragma unroll
            for (int j = 0; j < 4; ++j) *(float*)(sb + voff + j * BV * 4) = acc[rt][4 * g + j]; }
        asm volatile("" ::: "memory");
    }
}
__device__ __forceinline__ void b1_unit(Ctx& C, int u) {
    const int sc = u & 31, bh = u >> 5, h = bh & 3, b = bh >> 2; const int row0 = b * SEQ + sc * 256;
    const int r32 = C.lane & 31, hi = C.lane >> 5;
    load_head(C, h);
    f32x16 acc[4]; acc[0] = f32x16{}; acc[1] = f32x16{}; acc[2] = f32x16{}; acc[3] = f32x16{};
    float dprod = 1.f;
#pragma unroll 1
    for (int c = 0; c < 4; ++c) { stage_chunk<false>(C, row0 + 64 * c, 64, h); if (C.tid < 128) dprod *= ((const LAS float*)(C.lds + L_D))[C.tid]; mma_chunk<false, true>(C, acc, row0 + 64 * c, 64, h); }
    store_state(acc, (float*)(C.ws + WS_LS) + (size_t)u * BK_ * BV, C.wave, r32, hi);
    if (C.tid < 128) ((float*)(C.ws + WS_DSC))[u * 128 + C.tid] = dprod;
}
__device__ __forceinline__ void b2_scan(Ctx& C) {
    float* LS = (float*)(C.ws + WS_LS); const float* DSC = (const float*)(C.ws + WS_DSC);
    for (int q = C.bid * NTHR + C.tid; q < NB * BH * BK_ * BV / 4; q += C.G * NTHR) {
        const int bh = q >> 13, rem = q & 8191, i = rem >> 6, v4 = (rem & 63) * 4;
        f32x4 s = (f32x4){0.f, 0.f, 0.f, 0.f};
#pragma unroll 4
        for (int sc = 0; sc < 32; ++sc) { const int u = bh * 32 + sc; f32x4* p = (f32x4*)(LS + ((size_t)u * BK_ + i) * BV + v4); const float d = DSC[u * 128 + i]; s = s * d + *p; *p = s; }
        *(f32x4*)(C.out + OFF_GP + ((size_t)bh * BK_ + i) * BV + v4) = s;
    }
}
__device__ __forceinline__ void b3_unit(Ctx& C, int u) {
    const int sc = u & 31, bh = u >> 5, h = bh & 3, b = bh >> 2; const int row0 = b * SEQ + sc * 256;
    const int r32 = C.lane & 31, hi = C.lane >> 5;
    load_head(C, h);
    f32x16 acc[4];
    if (sc == 0) { acc[0] = f32x16{}; acc[1] = f32x16{}; acc[2] = f32x16{}; acc[3] = f32x16{}; }
    else load_state(acc, (const float*)(C.ws + WS_LS) + (size_t)(u - 1) * BK_ * BV, C.wave, r32, hi);
#pragma unroll 1
    for (int c = 0; c < 4; ++c) { stage_chunk<true>(C, row0 + 64 * c, 64, h); mma_chunk<true, true>(C, acc, row0 + 64 * c, 64, h); }
}
__device__ __forceinline__ void sample_unit(Ctx& C, int u) {
    const int h = u & 3, db = u >> 2; const int row0 = MP + db * DS;
    const int r32 = C.lane & 31, hi = C.lane >> 5;
    load_head(C, h);
    f32x16 acc[4];
    load_state(acc, INF(I_SG) + (size_t)u * BK_ * BV, C.wave, r32, hi);
    stage_chunk<true>(C, row0, DS, h); mma_chunk<true, true>(C, acc, row0, DS, h);
    store_state(acc, C.out + OFF_GS + (size_t)u * BK_ * BV, C.wave, r32, hi);
}
}
__device__ __forceinline__ void gla_post(Ctx& C) {
    const bf16* U = (const bf16*)(C.ws + WS_U); const float* OBR = (const float*)(C.ws + WS_OBR); bf16* OB = (bf16*)(C.ws + WS_OB);
    const int gw = C.bid * NWAVES + C.wave, NGW = C.G * NWAVES;
    const f32x4 gg = *(const f32x4*)(INF(I_GGLA) + C.lane * 4);
    for (int m0 = gw * 2; m0 < MT; m0 += NGW * 2) {
        f32x4 x[2][4]; v2u rb[2][4];
#pragma unroll
        for (int rr = 0; rr < 2; ++rr)
#pragma unroll
            for (int h = 0; h < 4; ++h) { x[rr][h] = *(const f32x4*)(OBR + (size_t)(m0 + rr) * BVW + h * 256 + C.lane * 4); rb[rr][h] = *(const v2u*)(U + (size_t)(m0 + rr) * NU + UC_RB + h * 256 + C.lane * 4); }
#pragma unroll
        for (int rr = 0; rr < 2; ++rr)
#pragma unroll
            for (int h = 0; h < 4; ++h) { const f32x4 xv = x[rr][h];
                const float r = 1.f / sqrtf(wave_sum((xv[0] * xv[0] + xv[1] * xv[1]) + (xv[2] * xv[2] + xv[3] * xv[3])) * (1.f / 256.f) + EPS);
                const float r0 = bflo(rb[rr][h].x), r1 = bfhi(rb[rr][h].x), r2 = bflo(rb[rr][h].y), r3 = bfhi(rb[rr][h].y);
                v2u w; w.x = pk2(xv[0] * r * gg[0] * r0 * sigmoidf_(r0), xv[1] * r * gg[1] * r1 * sigmoidf_(r1)); w.y = pk2(xv[2] * r * gg[2] * r2 * sigmoidf_(r2), xv[3] * r * gg[3] * r3 * sigmoidf_(r3));
                *(v2u*)(OB + (size_t)(m0 + rr) * BVW + h * 256 + C.lane * 4) = w; }
    }
}

__device__ __forceinline__ void p7_rows(Ctx& C) {
    const float* F1 = (const float*)(C.ws + WS_F1); float* X1 = (float*)(C.ws + WS_X1); bf16* XN2 = (bf16*)(C.ws + WS_XN2);
    const int gw = C.bid * NWAVES + C.wave, NGW = C.G * NWAVES, lane = C.lane;
    for (int m0 = gw * 2; m0 < MT; m0 += NGW * 2) {
        f32x4 f[2][4], x[2][4];
#pragma unroll
        for (int rr = 0; rr < 2; ++rr) { const int m = m0 + rr; const float* xr = m < MP ? INF(I_XP) + (size_t)m * DM : INF(I_XS) + (size_t)(m - MP) * DM;
#pragma unroll
            for (int j = 0; j < 4; ++j) { f[rr][j] = *((const f32x4*)(F1 + (size_t)m * DM) + lane + 64 * j); x[rr][j] = *((const f32x4*)xr + lane + 64 * j); } }
#pragma unroll
        for (int rr = 0; rr < 2; ++rr) { const int m = m0 + rr; float s = 0.f;
#pragma unroll
            for (int j = 0; j < 4; ++j) s += (f[rr][j].x * f[rr][j].x + f[rr][j].y * f[rr][j].y) + (f[rr][j].z * f[rr][j].z + f[rr][j].w * f[rr][j].w);
            const float r = 1.f / sqrtf(wave_sum(s) * (1.f / DM) + EPS); float s2 = 0.f;
#pragma unroll
            for (int j = 0; j < 4; ++j) { const f32x4 g = *((const f32x4*)INF(I_GPOM) + lane + 64 * j); x[rr][j] = x[rr][j] + f[rr][j] * r * g; s2 += (x[rr][j].x * x[rr][j].x + x[rr][j].y * x[rr][j].y) + (x[rr][j].z * x[rr][j].z + x[rr][j].w * x[rr][j].w);
                *((f32x4*)(X1 + (size_t)m * DM) + lane + 64 * j) = x[rr][j]; }
            const float r2 = 1.f / sqrtf(wave_sum(s2) * (1.f / DM) + EPS);
#pragma unroll
            for (int j = 0; j < 4; ++j) { const f32x4 g = *((const f32x4*)INF(I_GPF) + lane + 64 * j); v2u w; w.x = pk2(x[rr][j].x * r2 * g.x, x[rr][j].y * r2 * g.y); w.y = pk2(x[rr][j].z * r2 * g.z, x[rr][j].w * r2 * g.w);
                *((v2u*)(XN2 + (size_t)m * DM) + lane + 64 * j) = w; } }
    }
}
__device__ __forceinline__ void p11_rows(Ctx& C) {
    const float* F2 = (const float*)(C.ws + WS_F2); const float* X1 = (const float*)(C.ws + WS_X1);
    const int gw = C.bid * NWAVES + C.wave, NGW = C.G * NWAVES, lane = C.lane;
    for (int m0 = gw * 2; m0 < MT; m0 += NGW * 2) {
        f32x4 f[2][4], x[2][4];
#pragma unroll
        for (int rr = 0; rr < 2; ++rr)
#pragma unroll
            for (int j = 0; j < 4; ++j) { f[rr][j] = *((const f32x4*)(F2 + (size_t)(m0 + rr) * DM) + lane + 64 * j); x[rr][j] = *((const f32x4*)(X1 + (size_t)(m0 + rr) * DM) + lane + 64 * j); }
#pragma unroll
        for (int rr = 0; rr < 2; ++rr) { float s = 0.f;
#pragma unroll
            for (int j = 0; j < 4; ++j) s += (f[rr][j].x * f[rr][j].x + f[rr][j].y * f[rr][j].y) + (f[rr][j].z * f[rr][j].z + f[rr][j].w * f[rr][j].w);
            const float r = 1.f / sqrtf(wave_sum(s) * (1.f / DM) + EPS);
#pragma unroll
            for (int j = 0; j < 4; ++j) { const f32x4 g = *((const f32x4*)INF(I_GPOF) + lane + 64 * j);
                *((f32x4*)(C.out + OFF_YP + (size_t)(m0 + rr) * DM) + lane + 64 * j) = x[rr][j] + f[rr][j] * r * g; } }
    }
}
__device__ __forceinline__ float gelu_tanh(float g) { const float u = 0.7978845608028654f * (g + 0.044715f * g * g * g); const float e = __expf(2.f * u); const float th = 1.f - 2.f / (e + 1.f); return 0.5f * g * (1.f + th); }
__device__ __forceinline__ void unpack8(v4u w, float (&x)[8]) { x[0] = bflo(w.x); x[1] = bfhi(w.x); x[2] = bflo(w.y); x[3] = bfhi(w.y); x[4] = bflo(w.z); x[5] = bfhi(w.z); x[6] = bflo(w.w); x[7] = bfhi(w.w); }
constexpr int CONV_RB = 45;
__device__ __forceinline__ void p9_conv(Ctx& C) {
    const bf16* UU = (const bf16*)(C.ws + WS_UU); bf16* ACT = (bf16*)(C.ws + WS_ACT);
    const float* wc = INF(I_WCONV); const float* bc = INF(I_BCONV);
    constexpr int NG = DFF / 8, NBLK = (MT + CONV_RB - 1) / CONV_RB;
    for (int it = C.bid * NTHR + C.tid; it < NBLK * NG; it += C.G * NTHR) {
        const int blk = it / NG, j0 = (it - blk * NG) * 8; const int r0 = blk * CONV_RB, r1 = (r0 + CONV_RB) < MT ? (r0 + CONV_RB) : MT;
        float w0[2][8], w1[2][8], w2[2][8], bb[2][8];
#pragma unroll
        for (int hf = 0; hf < 2; ++hf)
#pragma unroll
            for (int i = 0; i < 8; ++i) { const int c = hf * DFF + j0 + i; w0[hf][i] = wc[c]; w1[hf][i] = wc[DFF2 + c]; w2[hf][i] = wc[2 * DFF2 + c]; bb[hf][i] = bc[c]; }
        float xa[2][8], xb[2][8];
        auto load_row = [&](int m, float (&o)[2][8]) {
            const v4u a = *(const v4u*)(UU + (size_t)m * DFF2 + j0), g = *(const v4u*)(UU + (size_t)m * DFF2 + DFF + j0); unpack8(a, o[0]); unpack8(g, o[1]); };
        auto load_hist = [&](int m, int back, float (&o)[2][8]) {
            const int t = m < MP ? (m & (SEQ - 1)) : ((m - MP) & 7);
            if (t - back >= 0) load_row(m - back, o);
            else if (m >= MP) { const float* sc = INF(I_SC) + ((size_t)((m - MP) >> 3) * 2 + (t - back + 2)) * DFF2;
#pragma unroll
                for (int i = 0; i < 8; ++i) { o[0][i] = sc[j0 + i]; o[1][i] = sc[DFF + j0 + i]; } }
            else {
#pragma unroll
                for (int i = 0; i < 8; ++i) { o[0][i] = 0.f; o[1][i] = 0.f; } } };
        load_hist(r0, 2, xa); load_hist(r0, 1, xb);
        float xc[2][8]; load_row(r0, xc);
        for (int m = r0; m < r1; ++m) {
            float xn[2][8];
            if (m + 1 < r1) load_row(m + 1, xn);
            const int t = m < MP ? (m & (SEQ - 1)) : ((m - MP) & 7);
            if (t == 0 && m != r0) { load_hist(m, 2, xa); load_hist(m, 1, xb); }
            else if (t == 1 && m != r0) { load_hist(m, 2, xa); }
            float ca[8], cg[8];
#pragma unroll
            for (int i = 0; i < 8; ++i) { ca[i] = bb[0][i] + xa[0][i] * w0[0][i] + xb[0][i] * w1[0][i] + xc[0][i] * w2[0][i]; cg[i] = bb[1][i] + xa[1][i] * w0[1][i] + xb[1][i] * w1[1][i] + xc[1][i] * w2[1][i]; }
            v4u w;
            w.x = pk2(gelu_tanh(cg[0]) * ca[0], gelu_tanh(cg[1]) * ca[1]); w.y = pk2(gelu_tanh(cg[2]) * ca[2], gelu_tanh(cg[3]) * ca[3]);
            w.z = pk2(gelu_tanh(cg[4]) * ca[4], gelu_tanh(cg[5]) * ca[5]); w.w = pk2(gelu_tanh(cg[6]) * ca[6], gelu_tanh(cg[7]) * ca[7]);
            *(v4u*)(ACT + (size_t)m * DFF + j0) = w;
#pragma unroll
            for (int hf = 0; hf < 2; ++hf)
#pragma unroll
                for (int i = 0; i < 8; ++i) { xa[hf][i] = xb[hf][i]; xb[hf][i] = xc[hf][i]; xc[hf][i] = xn[hf][i]; }
        }
    }
}

constexpr int NPHASE = 14;
__global__ void __launch_bounds__(NTHR, 2) mk_fwd(Args args) {
    extern __shared__ __attribute__((aligned(16))) unsigned char lds[];
    Ctx C;
    C.lds = (LAS unsigned char*)lds;
    C.tid = threadIdx.x; C.lane = C.tid & 63; C.wave = __builtin_amdgcn_readfirstlane(C.tid >> 6);
    C.G = gridDim.x; C.bid = blockIdx.x;
    C.ka = (const char KAS*)__builtin_amdgcn_kernarg_segment_ptr();
    C.out = *(float* const KAS*)(C.ka + 192); C.ws = *(unsigned char* const KAS*)(C.ka + 200);
    unsigned char* ws = C.ws;
    for (int u = C.tid; u < (LDS_BYTES - LDSCTL_OFF) / 4; u += NTHR) ((LAS unsigned*)(C.lds + LDSCTL_OFF))[u] = 0u;
    __syncthreads();
    const int lo = *(const int KAS*)(C.ka + 208), hi = *(const int KAS*)(C.ka + 212);
    const bool multi = (hi - lo) > 1;
    XcdBarrier bar; bar.bar = (unsigned*)(ws + WS_CTL) + CW_BAR; bar.x = 0; bar.st = nullptr;
    if (multi) bar = xcd_barrier_post((unsigned*)(ws + WS_CTL) + CW_BAR, (volatile LAS unsigned*)(C.lds + MISC_OFF) + 8);
#ifndef PHASE_MASK
#define PHASE_MASK 0xFFFF
#endif
#define IN(k) (((PHASE_MASK >> (k)) & 1) && lo <= (k) && (k) < hi)
#define SEAM(k) do { if (IN(k) && IN((k) + 1)) xcd_barrier(bar); } while (0)
#define REFRESH() do { int t_ = threadIdx.x; asm volatile("" : "+v"(t_)); C.tid = t_; C.lane = t_ & 63; } while (0)
    bf16* U = (bf16*)(ws + WS_U);

    if (IN(0)) { REFRESH(); p0_prologue(C); } SEAM(0);

    if (IN(1)) { REFRESH();
        pg8::Gemm g{(const bf16*)(ws + WS_XN), (const bf16*)(ws + WS_WIN), MT, NU, DM}; pg8::StaticOrder S; S.init(MT, NU, C.G, C.bid);
        pg8::EpiGen<StInProj> E{{U, C.out, (float*)(ws + WS_ALOW), (float*)(ws + WS_FA)}};
        pg8::gemm_phase<pg8::EpiGen<StInProj>, pg8::StaticOrder, true, true>(C.lds + RING_OFF, g, S, E);
    } SEAM(1);

    if (IN(2)) { REFRESH(); p2_scans(C); for (int u = C.bid; u < 256; u += C.G) gla::b1_unit(C, u); } SEAM(2);

    if (IN(3)) { REFRESH();
#ifndef MIX_ONLY_ATTN
        gla::b2_scan(C);
#endif
        for (int u = C.bid; u < 512; u += C.G) { const int qb = 31 - (u >> 4), bh = u & 15; att::attn_unit<8>(bh >> 3, bh & 7, qb, U, (const float*)(ws + WS_CB), (bf16*)(ws + WS_OA), C.lds + RING_OFF); }
#ifndef MIX_ONLY_ATTN
        for (int w = C.bid; w < 256; w += C.G) sattn_unit(C, w >> 3, w & 7);
        for (int w = C.G - 1 - C.bid; w < 128; w += C.G) gla::sample_unit(C, w);
#endif
    } SEAM(3);

    if (IN(4)) { REFRESH(); for (int u = C.bid; u < 256; u += C.G) gla::b3_unit(C, u); sattn_combine(C); } SEAM(4);

    if (IN(5)) { REFRESH(); gla_post(C); } SEAM(5);

    if (IN(6)) { REFRESH();
        pg8::Gemm g{(const bf16*)(ws + WS_OA), (const bf16*)(ws + WS_WPA), MT, DM, AW}; pg8::StaticOrder S; S.init(MT, DM, C.G, C.bid);
        pg8::EpiGen<StProjA> E{{U, (float*)(ws + WS_TA)}};
        pg8::gemm_phase<pg8::EpiGen<StProjA>, pg8::StaticOrder, true, true>(C.lds + RING_OFF, g, S, E);
    } SEAM(6);

    if (IN(7)) { REFRESH();
        pg8::Gemm g{(const bf16*)(ws + WS_OB), (const bf16*)(ws + WS_WPB), MT, DM, BVW}; pg8::StaticOrder S; S.init(MT, DM, C.G, C.bid);
        pg8::EpiGen<StProjB> E{{U, (const float*)(ws + WS_TA), (bf16*)(ws + WS_MG)}};
        pg8::gemm_phase<pg8::EpiGen<StProjB>, pg8::StaticOrder, true, true>(C.lds + RING_OFF, g, S, E);
    } SEAM(7);

    if (IN(8)) { REFRESH();
        pg8::Gemm g{(const bf16*)(ws + WS_MG), (const bf16*)(ws + WS_WOUT), MT, DM, DM}; pg8::StaticOrder S; S.init(MT, DM, C.G, C.bid);
        pg8::EpiGen<StF32> E{{(float*)(ws + WS_F1)}};
        pg8::gemm_phase<pg8::EpiGen<StF32>, pg8::StaticOrder, true, true>(C.lds + RING_OFF, g, S, E);
    } SEAM(8);

    if (IN(9)) { REFRESH(); p7_rows(C); } SEAM(9);

    if (IN(10)) { REFRESH();
        pg8::Gemm g{(const bf16*)(ws + WS_XN2), (const bf16*)(ws + WS_WUP), MT, DFF2, DM}; pg8::StaticOrder S; S.init(MT, DFF2, C.G, C.bid);
        pg8::EpiGen<StUp> E{{(bf16*)(ws + WS_UU), C.out}};
        pg8::gemm_phase<pg8::EpiGen<StUp>, pg8::StaticOrder, true, true>(C.lds + RING_OFF, g, S, E);
    } SEAM(10);

    if (IN(11)) { REFRESH(); p9_conv(C); } SEAM(11);

    if (IN(12)) { REFRESH();
        pg8::Gemm g{(const bf16*)(ws + WS_ACT), (const bf16*)(ws + WS_WDN), MT, DM, DFF}; pg8::StaticOrder S; S.init(MT, DM, C.G, C.bid);
        pg8::EpiGen<StF32> E{{(float*)(ws + WS_F2)}};
        pg8::gemm_phase<pg8::EpiGen<StF32>, pg8::StaticOrder, true, true>(C.lds + RING_OFF, g, S, E);
    } SEAM(12);

    if (IN(13)) { REFRESH(); p11_rows(C); }
#undef IN
#undef SEAM
}

#ifndef MK_SPLIT
#define MK_SPLIT 0
#endif
extern "C" void kernel_launch(void* const* d_in, const int* in_sizes, int n_in, void* d_out, int out_size, void* d_ws, size_t ws_size, hipStream_t stream) {
    static int grid = 0;
    if (grid == 0) {
        if (n_in != 24 || (size_t)out_size != OUT_TOTAL || ws_size < WS_END) { fprintf(stderr, "kernel_launch: unexpected problem (n_in %d, out %d, ws %zu)\n", n_in, out_size, ws_size); grid = -1; return; }
        int dev = 0, cus = 0, per_cu = 0;
        if (hipGetDevice(&dev) != hipSuccess || hipDeviceGetAttribute(&cus, hipDeviceAttributeMultiprocessorCount, dev) != hipSuccess) { grid = -1; return; }
        if (hipFuncSetAttribute((const void*)mk_fwd, hipFuncAttributeMaxDynamicSharedMemorySize, LDS_BYTES) != hipSuccess) { fprintf(stderr, "kernel_launch: hipFuncSetAttribute failed\n"); grid = -1; return; }
        if (hipOccupancyMaxActiveBlocksPerMultiprocessor(&per_cu, (const void*)mk_fwd, NTHR, LDS_BYTES) != hipSuccess || per_cu < 1) fprintf(stderr, "kernel_launch: occupancy query reports %d\n", per_cu);
        (void)hipGetLastError();
        grid = cus;
    }
    if (grid < 0) return;
    if (hipMemsetAsync((char*)d_ws + WS_CTL, 0, CTL_ZERO_BYTES, stream) != hipSuccess) return;
    Args a{};
    for (int i = 0; i < 24; ++i) a.in[i] = d_in[i];
    a.out = (float*)d_out; a.ws = (unsigned char*)d_ws;
#if MK_SPLIT
    for (int p = 0; p < NPHASE; ++p) { a.ph_lo = p; a.ph_hi = p + 1; hipLaunchKernelGGL(mk_fwd, dim3(grid), dim3(NTHR), LDS_BYTES, stream, a); }
#else
    a.ph_lo = 0; a.ph_hi = NPHASE;
    hipLaunchKernelGGL(mk_fwd, dim3(grid), dim3(NTHR), LDS_BYTES, stream, a);
#endif
    const hipError_t le = hipPeekAtLastError();
    if (le != hipSuccess) fprintf(stderr, "kernel_launch: launch failed: %s\n", hipGetErrorName(le));
}
```

```cpp
#include <hip/hip_runtime.h>
#include <cstdio>
#include <cstdint>
namespace pg8 {
#define PG8_LAS __attribute__((address_space(3)))
typedef unsigned short bf16_t;
typedef short bf16x8 __attribute__((ext_vector_type(8)));
typedef float f32x4 __attribute__((ext_vector_type(4)));
typedef unsigned u32x4 __attribute__((ext_vector_type(4)));
constexpr int BM = 256, BK = 64, HALF = 128, HTB = HALF * BK * 2  , STAGE_BYTES = 8 * HTB, NXCD = 8, WGM = 8;

__host__ __device__ __forceinline__ int lds_byte(int r, int c) { const int st = (r >> 4) * 2 + (c >> 5), rr = r & 15, cc = c & 31, ob = rr * 64 + cc * 2; return st * 1024 + (ob ^ (((ob >> 9) & 1) << 5)); }
__host__ __device__ __forceinline__ void stage_rc(int b, int& R, int& C) { const int st = b / 1024, sb = b % 1024, swz = sb ^ (((sb >> 9) & 1) << 5); R = (st >> 1) * 16 + swz / 64; C = (st & 1) * 32 + (swz % 64) / 2; }
__host__ __device__ __forceinline__ int perm32(int rho) { const int n = rho >> 4, i = rho & 15; return 8 * (i >> 2) + 4 * n + (i & 3); }

struct Unit { int pm, pn; };
struct Gemm { const bf16_t* A; const bf16_t* Bt; int M, N, K; };

struct StaticOrder {
    int nM, nN, nwg, G, c;
    __host__ __device__ void init(int M, int N, int G_, int c_) { nM = M / BM; nN = N / BM; nwg = nM * nN; G = G_; c = c_; }
    __host__ __device__ bool next(int i, Unit& u) const {
        const long L = (long)i * G + c; if (L >= nwg) return false;
        int wgid = (int)L; { const int q = nwg / NXCD, r = nwg % NXCD, xcd = wgid % NXCD, off = wgid / NXCD; wgid = (xcd < r ? xcd * (q + 1) : r * (q + 1) + (xcd - r) * q) + off; }
        const int nig = WGM * nN, gid = wgid / nig, fm = gid * WGM, gsz = (nM - fm) < WGM ? (nM - fm) : WGM;
        u.pm = fm + ((wgid % nig) % gsz); u.pn = (wgid % nig) / gsz; return true;
    }
    __device__ __forceinline__ void a_ready(const Unit&) const {}
    __device__ __forceinline__ void done(const Unit&) const {}
};

__device__ __forceinline__ unsigned cvt_pk_bf16(float lo, float hi) { unsigned r; asm volatile("v_cvt_pk_bf16_f32 %0, %1, %2" : "=v"(r) : "v"(lo), "v"(hi)); return r; }
typedef float f32x2 __attribute__((ext_vector_type(2)));

template <class F> struct EpiGen {
    static constexpr bool PERM = true, AFTER_DRAIN = false;
    F f;
    __device__ __forceinline__ void operator()(const f32x4 (&acc)[2][2][4][2], const Unit& u, int wr, int wc, int fr, int fq) const {
        const int row0 = u.pm * BM + wr * 64 + fr, col0 = u.pn * BM + wc * 32 + 8 * fq;
#pragma unroll
        for (int ai = 0; ai < 2; ++ai)
#pragma unroll
            for (int m = 0; m < 4; ++m)
#pragma unroll
                for (int bj = 0; bj < 2; ++bj)
                    f.store8(row0 + ai * HALF + m * 16, col0 + bj * HALF, u.pn, acc[ai][bj][m][0], acc[ai][bj][m][1]);
    }
};
template <class Epi, class Sched, bool ALIGN_EPI = false, bool SP2 = false>
__device__ __forceinline__ void gemm_phase(PG8_LAS unsigned char* lds, const Gemm g, const Sched& S, const Epi& E) {
    const int tid = threadIdx.x, wid = __builtin_amdgcn_readfirstlane(tid >> 6), lane = tid & 63, wr = wid >> 2, wc = wid & 3, fr = lane & 15, fq = lane >> 4;
    const int K = g.K, nt = K / BK;
    unsigned voffA[2], voffB[2];
#pragma unroll
    for (int i = 0; i < 2; ++i) { int R, C; stage_rc(tid * 16 + i * 8192, R, C); const int Rb = Epi::PERM ? ((R & ~31) + perm32(R & 31)) : R;
        voffA[i] = (unsigned)(R * K + C) * 2u; voffB[i] = (unsigned)(Rb * K + C) * 2u; }
    const size_t kstep = (size_t)(BK * 2);
    const size_t hstep = (size_t)HALF * K * 2;
    const size_t tstep = 2 * hstep;
    const unsigned ldsw = (unsigned)wid * 1024u;
    const int aoff = lds_byte(wr * 64 + fr, fq * 8), boff = lds_byte(wc * 32 + fr, fq * 8);
#define PG8_SA(b, h) (((b) * 2 + (h)) * HTB)
#define PG8_SB(b, h) ((4 + (b) * 2 + (h)) * HTB)
#define PG8_STAGE(bufoff, gbase, voff) do { _Pragma("unroll") for (int _i = 0; _i < 2; ++_i) \
        __builtin_amdgcn_global_load_lds((const unsigned*)((const char*)(gbase) + (voff)[_i]), (PG8_LAS unsigned*)(lds + (bufoff) + ldsw + _i * 8192), 16, 0, 0); } while (0)
#define PG8_LDA(dst, b, h) do { _Pragma("unroll") for (int m = 0; m < 4; ++m) _Pragma("unroll") for (int k = 0; k < 2; ++k) dst[m][k] = *(const PG8_LAS bf16x8*)(lds + PG8_SA(b, h) + aoff + m * 2048 + k * 1024); } while (0)
#define PG8_LDB(dst, b, h) do { _Pragma("unroll") for (int n = 0; n < 2; ++n) _Pragma("unroll") for (int k = 0; k < 2; ++k) dst[n][k] = *(const PG8_LAS bf16x8*)(lds + PG8_SB(b, h) + boff + n * 2048 + k * 1024); } while (0)
#define PG8_MMA(ai, bj, At, Bt) do { __builtin_amdgcn_s_setprio(1); _Pragma("unroll") for (int m = 0; m < 4; ++m) _Pragma("unroll") for (int n = 0; n < 2; ++n) _Pragma("unroll") for (int k = 0; k < 2; ++k) \
        acc[ai][bj][m][n] = __builtin_amdgcn_mfma_f32_16x16x32_bf16(Bt[n][k], At[m][k], acc[ai][bj][m][n], 0, 0, 0); __builtin_amdgcn_s_setprio(0); } while (0)
#define PG8_WAIT_V(n) asm volatile("s_waitcnt vmcnt(" #n ")" ::: "memory")
#define PG8_WAIT_L(n) asm volatile("s_waitcnt lgkmcnt(" #n ")" ::: "memory")
#define PG8_BAR __builtin_amdgcn_s_barrier()
#define PG8_SCHED __builtin_amdgcn_sched_barrier(0)
    Unit cur, nxt; int ui = 0;
    if (!S.next(0, cur)) return;
    f32x4 acc[2][2][4][2];
#pragma unroll
    for (int a = 0; a < 2; ++a)
#pragma unroll
        for (int b = 0; b < 2; ++b)
#pragma unroll
            for (int m = 0; m < 4; ++m)
#pragma unroll
                for (int n = 0; n < 2; ++n) acc[a][b][m][n] = (f32x4){0.f, 0.f, 0.f, 0.f};
    bf16x8 At[4][2], B0[2][2], B1[2][2];
    const char* cA = (const char*)g.A + (size_t)cur.pm * tstep; const char* cB = (const char*)g.Bt + (size_t)cur.pn * tstep;
    S.a_ready(cur);
    if constexpr (SP2) {
        PG8_STAGE(PG8_SB(0, 0), cB, voffB); PG8_STAGE(PG8_SB(0, 1), cB + hstep, voffB); PG8_STAGE(PG8_SA(0, 0), cA, voffA); PG8_STAGE(PG8_SA(0, 1), cA + hstep, voffA);
        if (wr == 1) PG8_BAR;
        PG8_WAIT_V(2); PG8_BAR;
        PG8_STAGE(PG8_SB(1, 0), cB + kstep, voffB); PG8_STAGE(PG8_SA(1, 0), cA + kstep, voffA); PG8_STAGE(PG8_SB(1, 1), cB + hstep + kstep, voffB);
        PG8_WAIT_V(6); PG8_BAR;
    } else {
        PG8_STAGE(PG8_SB(0, 0), cB, voffB); PG8_STAGE(PG8_SA(0, 0), cA, voffA); PG8_STAGE(PG8_SB(0, 1), cB + hstep, voffB); PG8_STAGE(PG8_SA(0, 1), cA + hstep, voffA);
        if (wr == 1) PG8_BAR;
        PG8_WAIT_V(4); PG8_BAR;
        PG8_STAGE(PG8_SB(1, 0), cB + kstep, voffB); PG8_STAGE(PG8_SA(1, 0), cA + kstep, voffA); PG8_STAGE(PG8_SB(1, 1), cB + hstep + kstep, voffB);
        PG8_WAIT_V(6); PG8_BAR;
    }
    for (;;) {
        const bool has_next = S.next(ui + 1, nxt);
        const char* nA = has_next ? (const char*)g.A + (size_t)nxt.pm * tstep : cA; const char* nB = has_next ? (const char*)g.Bt + (size_t)nxt.pn * tstep : cB;
        for (int t = 0; t < nt; t += 2) {
            const bool last = (t == nt - 2);
            const char* a1 = cA + (size_t)(t + 1) * kstep;
            const char* a2 = last ? nA : cA + (size_t)(t + 2) * kstep; const char* b2 = last ? nB : cB + (size_t)(t + 2) * kstep;
            const char* a3 = a2 + kstep; const char* b3 = b2 + kstep;
            if (last && has_next) S.a_ready(nxt);
            if constexpr (SP2) {
            PG8_LDB(B0, 0, 0); PG8_LDB(B1, 0, 1); PG8_SCHED; PG8_LDA(At, 0, 0); PG8_STAGE(PG8_SA(1, 1), a1 + hstep, voffA);
            PG8_WAIT_V(8); PG8_WAIT_L(0); PG8_BAR; PG8_MMA(0, 0, At, B0); PG8_MMA(0, 1, At, B1); PG8_BAR; PG8_SCHED;
            PG8_LDA(At, 0, 1); PG8_STAGE(PG8_SB(0, 0), b2, voffB); PG8_STAGE(PG8_SB(0, 1), b2 + hstep, voffB); PG8_STAGE(PG8_SA(0, 0), a2, voffA);
            PG8_WAIT_V(8); PG8_WAIT_L(0); PG8_BAR; PG8_MMA(1, 0, At, B0); PG8_MMA(1, 1, At, B1); PG8_BAR; PG8_SCHED;
            PG8_LDB(B0, 1, 0); PG8_LDB(B1, 1, 1); PG8_SCHED; PG8_LDA(At, 1, 0); PG8_STAGE(PG8_SA(0, 1), a2 + hstep, voffA);
            PG8_WAIT_V(8); PG8_WAIT_L(0); PG8_BAR; PG8_MMA(0, 0, At, B0); PG8_MMA(0, 1, At, B1); PG8_BAR; PG8_SCHED;
            PG8_LDA(At, 1, 1); PG8_STAGE(PG8_SB(1, 0), b3, voffB); PG8_STAGE(PG8_SB(1, 1), b3 + hstep, voffB); PG8_STAGE(PG8_SA(1, 0), a3, voffA);
            PG8_WAIT_V(8); PG8_WAIT_L(0); PG8_BAR; PG8_MMA(1, 0, At, B0); PG8_MMA(1, 1, At, B1); PG8_BAR; PG8_SCHED;
            } else {
            PG8_LDB(B0, 0, 0); PG8_SCHED; PG8_LDA(At, 0, 0); PG8_STAGE(PG8_SA(1, 1), a1 + hstep, voffA);
            PG8_WAIT_L(8); PG8_BAR; PG8_WAIT_L(0); PG8_MMA(0, 0, At, B0); PG8_BAR; PG8_SCHED;
            PG8_LDB(B1, 0, 1); PG8_STAGE(PG8_SB(0, 0), b2, voffB);
            PG8_BAR; PG8_WAIT_L(0); PG8_MMA(0, 1, At, B1); PG8_BAR;
            PG8_LDA(At, 0, 1); PG8_STAGE(PG8_SA(0, 0), a2, voffA);
            PG8_BAR; PG8_WAIT_L(0); PG8_MMA(1, 0, At, B0); PG8_BAR; PG8_SCHED;
            PG8_STAGE(PG8_SB(0, 1), b2 + hstep, voffB);
            PG8_WAIT_V(6); PG8_BAR; PG8_MMA(1, 1, At, B1); PG8_BAR;
            PG8_LDB(B0, 1, 0); PG8_SCHED; PG8_LDA(At, 1, 0); PG8_STAGE(PG8_SA(0, 1), a2 + hstep, voffA);
            PG8_WAIT_L(8); PG8_BAR; PG8_WAIT_L(0); PG8_MMA(0, 0, At, B0); PG8_BAR; PG8_SCHED;
            PG8_LDB(B1, 1, 1); PG8_STAGE(PG8_SB(1, 0), b3, voffB);
            PG8_BAR; PG8_WAIT_L(0); PG8_MMA(0, 1, At, B1); PG8_BAR;
            PG8_LDA(At, 1, 1); PG8_STAGE(PG8_SA(1, 0), a3, voffA);
            PG8_BAR; PG8_WAIT_L(0); PG8_MMA(1, 0, At, B0); PG8_BAR; PG8_SCHED;
            PG8_STAGE(PG8_SB(1, 1), b3 + hstep, voffB);
            PG8_WAIT_V(6); PG8_BAR; PG8_MMA(1, 1, At, B1); PG8_BAR;
            }
        }
        if constexpr (ALIGN_EPI) { if (wr == 0) PG8_BAR; }
        if constexpr (!Epi::AFTER_DRAIN) { E(acc, cur, wr, wc, fr, fq); S.done(cur); }
        if (!has_next) break;
#pragma unroll
        for (int a = 0; a < 2; ++a)
#pragma unroll
            for (int b = 0; b < 2; ++b)
#pragma unroll
                for (int m = 0; m < 4; ++m)
#pragma unroll
                    for (int n = 0; n < 2; ++n) acc[a][b][m][n] = (f32x4){0.f, 0.f, 0.f, 0.f};
        cur = nxt; cA = nA; cB = nB; ++ui;
        if constexpr (ALIGN_EPI) { if (wr == 1) PG8_BAR; }
    }
    PG8_WAIT_V(0);
    if constexpr (!ALIGN_EPI) { if (wr == 0) PG8_BAR; }
    PG8_BAR;
    if constexpr (Epi::AFTER_DRAIN) { E.fused(acc, cur, wr, wc, fr, fq, lds, wid, lane); S.done(cur); }
#undef PG8_SA
#undef PG8_SB
#undef PG8_STAGE
#undef PG8_LDA
#undef PG8_LDB
#undef PG8_MMA
#undef PG8_WAIT_V
#undef PG8_WAIT_L
#undef PG8_BAR
#undef PG8_SCHED
}
}
#define GAS __attribute__((address_space(1)))
#define LAS __attribute__((address_space(3)))
typedef unsigned short bf16;
typedef unsigned v4u __attribute__((ext_vector_type(4)));
typedef float f32x4 __attribute__((ext_vector_type(4)));
typedef short bf16x8 __attribute__((ext_vector_type(8)));
typedef GAS unsigned gu32;
typedef GAS unsigned long long gu64;
#define RLX_AGENT __ATOMIC_RELAXED, __HIP_MEMORY_SCOPE_AGENT
#define LDS_WAIT() asm volatile("s_waitcnt lgkmcnt(0)" ::: "memory")
#define VM_WAIT() asm volatile("s_waitcnt vmcnt(0)" ::: "memory")
__device__ __forceinline__ unsigned long long rt() { return __builtin_amdgcn_s_memrealtime(); }
__device__ __forceinline__ unsigned f2bf(float f) { unsigned u = __builtin_bit_cast(unsigned, f); return (u + 0x7fffu + ((u >> 16) & 1u)) >> 16; }
__device__ __forceinline__ unsigned pk2(float lo, float hi) { return f2bf(lo) | (f2bf(hi) << 16); }

#define XB_TMO      128
#define XB_XCNT(j)  (256  + 64 * (j))
#define XB_XSUB(j)  (1280 + 64 * (j))
#define XB_XGEN(j)  (2304 + 64 * (j))
#define XB_TOP      3328
#define XB_TOPGEN   3392
#define XCD_BAR_WORDS 3456
#define XB_SPIN_CAP (1u << 18)

__device__ __forceinline__ unsigned xb_ld(unsigned* p)              { return __hip_atomic_load(p, __ATOMIC_RELAXED, __HIP_MEMORY_SCOPE_AGENT); }
__device__ __forceinline__ unsigned xb_add(unsigned* p, unsigned v) { return __hip_atomic_fetch_add(p, v, __ATOMIC_RELAXED, __HIP_MEMORY_SCOPE_AGENT); }
__device__ __forceinline__ unsigned xb_xcc_id() { return (unsigned)__builtin_amdgcn_s_getreg((3 << 11) | 20) & 0xFu; }
#define XB_SPIN(cond, bar) do { unsigned _sp = 0; while (cond) { __builtin_amdgcn_s_sleep(1); \
    if ((++_sp & 255u) == 0u) { if (xb_ld(&(bar)[XB_TMO])) break; if (_sp > XB_SPIN_CAP) { atomicAdd(&(bar)[XB_TMO], 1u); break; } } } } while (0)

struct XcdBarrier {
    unsigned* bar; unsigned x;
    volatile LAS unsigned* st;
};

__device__ __forceinline__ XcdBarrier xcd_barrier_post(unsigned* bar, volatile LAS unsigned* st) {
    XcdBarrier b; b.bar = bar; b.x = xb_xcc_id(); b.st = st;
    if (threadIdx.x == 0) (void)xb_add(&bar[XB_XCNT(b.x)], 1u);
    return b;
}
__device__ __forceinline__ void xcd_barrier_complete(unsigned* bar, unsigned x, unsigned& nloc, unsigned& nx) {
    const unsigned G = gridDim.x * gridDim.y * gridDim.z;
    unsigned sum, cnt, mine, sp = 0u;
    for (;;) {
        sum = 0u; cnt = 0u; mine = 0u;
#pragma unroll
        for (unsigned j = 0; j < 16; ++j) { const unsigned c = xb_ld(&bar[XB_XCNT(j)]); sum += c; cnt += (c > 0u) ? 1u : 0u; mine = (j == x) ? c : mine; }
        if (sum == G) break;
        __builtin_amdgcn_s_sleep(1);
        if ((++sp & 255u) == 0u) { if (xb_ld(&bar[XB_TMO])) break; if (sp > XB_SPIN_CAP) { atomicAdd(&bar[XB_TMO], 1u); break; } }
    }
    nloc = mine > 0u ? mine : 1u; nx = cnt > 0u ? cnt : 1u;
}

__device__ __forceinline__ void xcd_barrier(const XcdBarrier& b) {
    asm volatile("s_waitcnt vmcnt(0)" ::: "memory");
    __syncthreads();
    if (threadIdx.x == 0) {
        unsigned* bar = b.bar;
        __builtin_amdgcn_s_waitcnt(0);
        unsigned nloc = b.st[0], nx = b.st[1];
        if (nloc == 0u) { xcd_barrier_complete(bar, b.x, nloc, nx); b.st[0] = nloc; b.st[1] = nx; }
        const unsigned old = xb_add(&bar[XB_XSUB(b.x)], 1u);
        const unsigned gen = old / nloc;
        if (old + 1u == (gen + 1u) * nloc) {
            __builtin_amdgcn_fence(__ATOMIC_RELEASE, "agent");
            asm volatile("s_waitcnt vmcnt(0)" ::: "memory");
            const unsigned og = xb_add(&bar[XB_TOP], 1u);
            const unsigned tg = og / nx;
            if (og + 1u == (tg + 1u) * nx) xb_add(&bar[XB_TOPGEN], 1u);
            else XB_SPIN(xb_ld(&bar[XB_TOPGEN]) == tg, bar);
            __builtin_amdgcn_fence(__ATOMIC_ACQUIRE, "agent");
            xb_add(&bar[XB_XGEN(b.x)], 1u);
            asm volatile("s_waitcnt vmcnt(0)" ::: "memory");
        } else {
            XB_SPIN(xb_ld(&bar[XB_XGEN(b.x)]) == gen, bar);
            __builtin_amdgcn_fence(__ATOMIC_ACQUIRE, "agent");
            asm volatile("s_waitcnt vmcnt(0)" ::: "memory");
        }
    }
    __syncthreads();
}

constexpr int NWAVES = 8, NTHR = 512;
constexpr int DM = 1024, SEQ = 8192, NB = 2, MP = NB * SEQ;
constexpr int DB = 32, DS = 8, MS = DB * DS, MT = MP + MS;
constexpr int AH = 8, AD = 64, AW = 512;
constexpr int BH = 4, BK_ = 128, BV = 256, BKW = 512, BVW = 1024, GR = 16;
constexpr int DFF = 2816, DFF2 = 5632;
constexpr int PAST = 8192, PAGE = 128, NPAGES = 64;
constexpr int DIN = 6680, NU = 6912;
constexpr int UC_QA = 0, UC_KA = 512, UC_VA = 1024, UC_QB = 1536, UC_KB = 2048, UC_VB = 2560, UC_RB = 3584, UC_GA = 4608, UC_GB = 5632, UC_FA = 6656, UC_AL = 6664;
constexpr float EPS = 1e-6f;
constexpr float LOG2E = 1.4426950408889634f;
constexpr float C2 = 0.125f * LOG2E;
constexpr float QB_SCALE = 0.08838834764831845f;
constexpr size_t OFF_YP = 0, OFF_YS = (size_t)MP * DM, OFF_KP = OFF_YS + (size_t)MS * DM, OFF_VP = OFF_KP + (size_t)MP * AW, OFF_FP = OFF_VP + (size_t)MP * AW,
                 OFF_GP = OFF_FP + (size_t)MP * AH, OFF_CP = OFF_GP + (size_t)NB * BH * BK_ * BV, OFF_KS = OFF_CP + (size_t)NB * 2 * DFF2, OFF_VS = OFF_KS + (size_t)MS * AW,
                 OFF_FS = OFF_VS + (size_t)MS * AW, OFF_GS = OFF_FS + (size_t)MS * AH, OFF_CS = OFF_GS + (size_t)DB * BH * BK_ * BV, OUT_TOTAL = OFF_CS + (size_t)DB * 2 * DFF2;
static_assert(OUT_TOTAL == 39051264, "output size");

constexpr size_t MiB = 1u << 20;
constexpr size_t WS_CTL = 0, CTL_ZERO_BYTES = 1 * MiB;
constexpr size_t al_(size_t x) { return (x + (MiB - 1)) & ~(MiB - 1); }
constexpr size_t WS_WIN = al_(WS_CTL + CTL_ZERO_BYTES);
constexpr size_t WS_WPA = al_(WS_WIN + (size_t)NU * DM * 2);
constexpr size_t WS_WPB = al_(WS_WPA + (size_t)DM * AW * 2);
constexpr size_t WS_WOUT = al_(WS_WPB + (size_t)DM * BVW * 2);
constexpr size_t WS_WUP = al_(WS_WOUT + (size_t)DM * DM * 2);
constexpr size_t WS_WDN = al_(WS_WUP + (size_t)DFF2 * DM * 2);
constexpr size_t WS_ALOW = al_(WS_WDN + (size_t)DM * DFF * 2);
constexpr size_t WS_FA = al_(WS_ALOW + (size_t)MT * GR * 4);
constexpr size_t WS_CB = al_(WS_FA + (size_t)MT * AH * 4);
constexpr size_t WS_SB = al_(WS_CB + (size_t)NB * AH * SEQ * 4);
constexpr size_t WS_PART = al_(WS_SB + (size_t)DB * AH * PAST * 4);
constexpr size_t WS_XN = al_(WS_PART + (size_t)256 * AH * DS * 68 * 4);
constexpr size_t WS_OA = al_(WS_XN + (size_t)MT * DM * 2);
constexpr size_t WS_OB = al_(WS_OA + (size_t)MT * AW * 2);
constexpr size_t WS_MG = al_(WS_OB + (size_t)MT * BVW * 2);
constexpr size_t WS_XN2 = al_(WS_MG + (size_t)MT * DM * 2);
constexpr size_t WS_ACT = al_(WS_XN2 + (size_t)MT * DM * 2);
constexpr size_t WS_U = al_(WS_ACT + (size_t)MT * DFF * 2);
constexpr size_t WS_UU = al_(WS_U + (size_t)MT * NU * 2);
constexpr size_t WS_OBR = al_(WS_UU + (size_t)MT * DFF2 * 2);
constexpr size_t WS_TA = al_(WS_OBR + (size_t)MT * BVW * 4);
constexpr size_t WS_F1 = al_(WS_TA + (size_t)MT * DM * 4);
constexpr size_t WS_X1 = al_(WS_F1 + (size_t)MT * DM * 4);
constexpr size_t WS_F2 = al_(WS_X1 + (size_t)MT * DM * 4);
constexpr size_t WS_LS = al_(WS_F2 + (size_t)MT * DM * 4);
constexpr size_t WS_DSC = al_(WS_LS + (size_t)256 * BK_ * BV * 4);
constexpr size_t WS_END = al_(WS_DSC + (size_t)256 * BK_ * 4);
static_assert(WS_END < (size_t)2600 * MiB, "workspace");
constexpr int CW_BAR = 4096;
constexpr int CW_Q = 8192;
constexpr int PART_STRIDE = 68;

constexpr int RING_OFF = 0, RING_BYTES = 147456;
constexpr int LDSCTL_OFF = RING_BYTES, MISC_OFF = LDSCTL_OFF + 320;
constexpr int LDS_BYTES = 151552;

typedef unsigned short bf16;
typedef unsigned v4u __attribute__((ext_vector_type(4)));
typedef unsigned v2u __attribute__((ext_vector_type(2)));
typedef float f32x4 __attribute__((ext_vector_type(4)));
typedef float f32x16 __attribute__((ext_vector_type(16)));
typedef short bf16x8 __attribute__((ext_vector_type(8)));
typedef short s16x4 __attribute__((ext_vector_type(4)));
typedef float f32x2v __attribute__((ext_vector_type(2)));

__device__ __forceinline__ float bf2f(unsigned short u) { return __uint_as_float((unsigned)u << 16); }
__device__ __forceinline__ float bflo(unsigned u) { return __uint_as_float(u << 16); }
__device__ __forceinline__ float bfhi(unsigned u) { return __uint_as_float(u & 0xffff0000u); }
__device__ __forceinline__ float sigmoidf_(float x) { return 1.f / (1.f + __expf(-x)); }
__device__ __forceinline__ float logsigmoidf_(float x) { return fminf(x, 0.f) - log1pf(expf(-fabsf(x))); }
__device__ __forceinline__ float wave_sum(float v) {
#pragma unroll
    for (int o = 1; o < 64; o <<= 1) v += __shfl_xor(v, o);
    return v;
}

#define KAS __attribute__((address_space(4)))
struct Ctx {
    LAS unsigned char* lds;
    int tid, lane, wave, G, bid;
    const char KAS* ka;
    float* out; unsigned char* ws;
};
struct Args { const void* in[24]; float* out; unsigned char* ws; int ph_lo, ph_hi; };
#define INF(k) (*(const float* const KAS*)(C.ka + 8 * (k)))
enum { I_XP = 0, I_XS, I_CK, I_CV, I_CF, I_SG, I_SC, I_PT, I_GPM, I_WIN, I_BF, I_WA2, I_BA, I_GGLA, I_WPA, I_WPB, I_WOUT, I_GPOM, I_GPF, I_WUP, I_WCONV, I_BCONV, I_WDN, I_GPOF };

__device__ __forceinline__ void transpose_item(const float* W, int ldw, int c0, int ncols, int K, bf16* WT, int r0, LAS float* scr, int item, int lane) {
    const int nblk = (ncols + 31) / 32, kb = item / nblk, nb = item % nblk, k0 = 64 * kb, n0 = 32 * nb;
    const bool cok = (n0 + (lane & 31)) < ncols;
    float tv[32];
#pragma unroll
    for (int i = 0; i < 32; ++i) { const int kk = 2 * i + (lane >> 5); tv[i] = cok ? W[(size_t)(k0 + kk) * ldw + c0 + n0 + (lane & 31)] : 0.f; }
#pragma unroll
    for (int i = 0; i < 32; ++i) { const int kk = 2 * i + (lane >> 5); scr[kk * 33 + (lane & 31)] = tv[i]; }
    LDS_WAIT(); asm volatile("" ::: "memory");
    const int c = lane & 7;
#pragma unroll
    for (int j = 0; j < 4; ++j) { const int n = (lane >> 3) + 8 * j; const LAS float* s = scr + (8 * c) * 33 + n;
        v4u o; o.x = pk2(s[0 * 33], s[1 * 33]); o.y = pk2(s[2 * 33], s[3 * 33]); o.z = pk2(s[4 * 33], s[5 * 33]); o.w = pk2(s[6 * 33], s[7 * 33]);
        if (n0 + n < ncols) *(GAS v4u*)(WT + (size_t)(r0 + n0 + n) * K + k0 + 8 * c) = o; }
    LDS_WAIT(); asm volatile("" ::: "memory");
}
__device__ __forceinline__ void rms_row_to_bf16(const float* xrow, const float* g, bf16* orow, int lane) {
    const GAS f32x4* xr = (const GAS f32x4*)xrow + lane; const GAS f32x4* gr = (const GAS f32x4*)g + lane;
    f32x4 v[4]; float s = 0.f;
#pragma unroll
    for (int j = 0; j < 4; ++j) { v[j] = xr[64 * j]; s += (v[j].x * v[j].x + v[j].y * v[j].y) + (v[j].z * v[j].z + v[j].w * v[j].w); }
    const float r = 1.f / sqrtf(wave_sum(s) * (1.f / DM) + EPS);
    GAS unsigned long long* o8 = (GAS unsigned long long*)orow + lane;
#pragma unroll
    for (int j = 0; j < 4; ++j) { const f32x4 gg = gr[64 * j]; o8[64 * j] = (unsigned long long)pk2(v[j].x * r * gg.x, v[j].y * r * gg.y) | ((unsigned long long)pk2(v[j].z * r * gg.z, v[j].w * r * gg.w) << 32); }
}
struct TSeg { int src, ldw, c0, ncols, K, dst, r0; };
__device__ __forceinline__ void rms_row2_to_bf16(const float* x0, const float* x1, const float* g, bf16* orow, int lane) {
    const GAS f32x4* a = (const GAS f32x4*)x0 + lane; const GAS f32x4* b = (const GAS f32x4*)x1 + lane; const GAS f32x4* gr = (const GAS f32x4*)g + lane;
    f32x4 v[4], w[4]; float s = 0.f, t = 0.f;
#pragma unroll
    for (int j = 0; j < 4; ++j) { v[j] = a[64 * j]; w[j] = b[64 * j]; }
#pragma unroll
    for (int j = 0; j < 4; ++j) { s += (v[j].x * v[j].x + v[j].y * v[j].y) + (v[j].z * v[j].z + v[j].w * v[j].w); t += (w[j].x * w[j].x + w[j].y * w[j].y) + (w[j].z * w[j].z + w[j].w * w[j].w); }
    const float r = 1.f / sqrtf(wave_sum(s) * (1.f / DM) + EPS), q = 1.f / sqrtf(wave_sum(t) * (1.f / DM) + EPS);
    GAS unsigned long long* o8 = (GAS unsigned long long*)orow + lane;
#pragma unroll
    for (int j = 0; j < 4; ++j) { const f32x4 gg = gr[64 * j];
        o8[64 * j] = (unsigned long long)pk2(v[j].x * r * gg.x, v[j].y * r * gg.y) | ((unsigned long long)pk2(v[j].z * r * gg.z, v[j].w * r * gg.w) << 32);
        o8[256 + 64 * j] = (unsigned long long)pk2(w[j].x * q * gg.x, w[j].y * q * gg.y) | ((unsigned long long)pk2(w[j].z * q * gg.z, w[j].w * q * gg.w) << 32); }
}
__device__ __forceinline__ void p0_prologue(Ctx& C) {
    LAS float* scr = (LAS float*)(C.lds + RING_OFF + C.wave * 16384);
    const int gw = C.bid * NWAVES + C.wave, NGW = C.G * NWAVES;
    bf16* Win = (bf16*)(C.ws + WS_WIN);
#define NI(w, K) ((((w) + 31) / 32) * ((K) / 64))
    constexpr int n0 = NI(512, DM), n1 = NI(1024, DM), n2 = NI(8, DM), n3 = NI(16, DM);
    constexpr int T_WIN = 5 * n0 + 4 * n1 + n2 + n3, T_WPA = NI(DM, AW), T_WPB = NI(DM, BVW), T_WOUT = NI(DM, DM), T_WUP = NI(DFF2, DM), T_WDN = NI(DM, DFF);
    constexpr int TOTAL = T_WIN + T_WPA + T_WPB + T_WOUT + T_WUP + T_WDN;
    for (int it0 = gw; it0 < TOTAL; it0 += NGW) {
        int it = it0;
#define SEG(c0, w, r0) if (it < NI(w, DM)) { transpose_item(INF(I_WIN), DIN, (c0), (w), DM, Win, (r0), scr, it, C.lane); continue; } it -= NI(w, DM);
        SEG(0, 512, UC_QA) SEG(512, 512, UC_KA) SEG(1024, 512, UC_VA) SEG(1536, 8, UC_FA) SEG(1544, 512, UC_QB) SEG(2056, 512, UC_KB)
        SEG(2568, 1024, UC_VB) SEG(3592, 16, UC_AL) SEG(3608, 1024, UC_RB) SEG(4632, 1024, UC_GA) SEG(5656, 1024, UC_GB)
#undef SEG
        if (it < T_WPA) { transpose_item(INF(I_WPA), DM, 0, DM, AW, (bf16*)(C.ws + WS_WPA), 0, scr, it, C.lane); continue; } it -= T_WPA;
        if (it < T_WPB) { transpose_item(INF(I_WPB), DM, 0, DM, BVW, (bf16*)(C.ws + WS_WPB), 0, scr, it, C.lane); continue; } it -= T_WPB;
        if (it < T_WOUT) { transpose_item(INF(I_WOUT), DM, 0, DM, DM, (bf16*)(C.ws + WS_WOUT), 0, scr, it, C.lane); continue; } it -= T_WOUT;
        if (it < T_WUP) { transpose_item(INF(I_WUP), DFF2, 0, DFF2, DM, (bf16*)(C.ws + WS_WUP), 0, scr, it, C.lane); continue; } it -= T_WUP;
        transpose_item(INF(I_WDN), DM, 0, DM, DFF, (bf16*)(C.ws + WS_WDN), 0, scr, it, C.lane);
    }
#undef NI
    { const int n16 = (NU - DIN) * DM * 2 / 16; GAS v4u* z = (GAS v4u*)(Win + (size_t)DIN * DM);
      for (int i = C.bid * NTHR + C.tid; i < n16; i += C.G * NTHR) z[i] = (v4u){0u, 0u, 0u, 0u}; }
    bf16* XN = (bf16*)(C.ws + WS_XN);
    for (int m = (NGW - 1 - gw) * 2; m < MT; m += NGW * 2) {
        const float* xr0 = m < MP ? INF(I_XP) + (size_t)m * DM : INF(I_XS) + (size_t)(m - MP) * DM; const float* xr1 = xr0 + DM;
        rms_row2_to_bf16(xr0, xr1, INF(I_GPM), XN + (size_t)m * DM, C.lane);
    }
}

__device__ __forceinline__ v4u pack8(f32x4 a, f32x4 b, float s) { v4u w; w.x = pg8::cvt_pk_bf16(a[0] * s, a[1] * s); w.y = pg8::cvt_pk_bf16(a[2] * s, a[3] * s); w.z = pg8::cvt_pk_bf16(b[0] * s, b[1] * s); w.w = pg8::cvt_pk_bf16(b[2] * s, b[3] * s); return w; }
struct StInProj {
    bf16* U; float* out; float* alow; float* fa;
    __device__ __forceinline__ void store8(int row, int col, int pn, f32x4 a, f32x4 b) const {
        if (pn == 26) {
            if (col == UC_FA) {
                float* dst = fa + (size_t)row * AH;
                *(f32x4*)dst = a; *(f32x4*)(dst + 4) = b;
            } else if (col == UC_AL || col == UC_AL + 8) {
                float* dst = alow + (size_t)row * GR + (col - UC_AL);
                *(f32x4*)dst = a; *(f32x4*)(dst + 4) = b;
            }
            return;
        }
        const float sc = pn < 2 ? C2 : ((pn == 6 || pn == 7) ? QB_SCALE : 1.f);
        *(v4u*)(U + (size_t)row * NU + col) = pack8(a, b, sc);
        if (pn >= 2 && pn < 6) {
            float* dst;
            if (pn < 4) dst = (row < MP ? out + OFF_KP + (size_t)row * AW : out + OFF_KS + (size_t)(row - MP) * AW) + (col - UC_KA);
            else        dst = (row < MP ? out + OFF_VP + (size_t)row * AW : out + OFF_VS + (size_t)(row - MP) * AW) + (col - UC_VA);
            *(f32x4*)dst = a; *(f32x4*)(dst + 4) = b;
        }
    }
};
struct StProjA {
    const bf16* U; float* TA;
    __device__ __forceinline__ void store8(int row, int col, int, f32x4 a, f32x4 b) const {
        const v4u g = *(const v4u*)(U + (size_t)row * NU + UC_GA + col);
        f32x4 x, y;
        x[0] = a[0] * sigmoidf_(bflo(g.x)); x[1] = a[1] * sigmoidf_(bfhi(g.x)); x[2] = a[2] * sigmoidf_(bflo(g.y)); x[3] = a[3] * sigmoidf_(bfhi(g.y));
        y[0] = b[0] * sigmoidf_(bflo(g.z)); y[1] = b[1] * sigmoidf_(bfhi(g.z)); y[2] = b[2] * sigmoidf_(bflo(g.w)); y[3] = b[3] * sigmoidf_(bfhi(g.w));
        float* dst = TA + (size_t)row * DM + col; *(f32x4*)dst = x; *(f32x4*)(dst + 4) = y;
    }
};
struct StProjB {
    const bf16* U; const float* TA; bf16* MG;
    __device__ __forceinline__ void store8(int row, int col, int, f32x4 a, f32x4 b) const {
        const v4u g = *(const v4u*)(U + (size_t)row * NU + UC_GB + col);
        const float* src = TA + (size_t)row * DM + col; const f32x4 t0 = *(const f32x4*)src, t1 = *(const f32x4*)(src + 4);
        f32x4 x, y;
        x[0] = t0[0] + a[0] * sigmoidf_(bflo(g.x)); x[1] = t0[1] + a[1] * sigmoidf_(bfhi(g.x)); x[2] = t0[2] + a[2] * sigmoidf_(bflo(g.y)); x[3] = t0[3] + a[3] * sigmoidf_(bfhi(g.y));
        y[0] = t1[0] + b[0] * sigmoidf_(bflo(g.z)); y[1] = t1[1] + b[1] * sigmoidf_(bfhi(g.z)); y[2] = t1[2] + b[2] * sigmoidf_(bflo(g.w)); y[3] = t1[3] + b[3] * sigmoidf_(bfhi(g.w));
        *(v4u*)(MG + (size_t)row * DM + col) = pack8(x, y, 1.f);
    }
};
struct StF32 {
    float* O;
    __device__ __forceinline__ void store8(int row, int col, int, f32x4 a, f32x4 b) const { float* dst = O + (size_t)row * DM + col; *(f32x4*)dst = a; *(f32x4*)(dst + 4) = b; }
};
struct StUp {
    bf16* UU; float* out;
    __device__ __forceinline__ void store8(int row, int col, int, f32x4 a, f32x4 b) const {
        *(v4u*)(UU + (size_t)row * DFF2 + col) = pack8(a, b, 1.f);
        float* dst = nullptr;
        if (row < MP) { const int t = row & (SEQ - 1); if (t >= SEQ - 2) dst = out + OFF_CP + ((size_t)(row >> 13) * 2 + (t - (SEQ - 2))) * DFF2 + col; }
        else { const int r = row - MP, t = r & 7; if (t >= 6) dst = out + OFF_CS + ((size_t)(r >> 3) * 2 + (t - 6)) * DFF2 + col; }
        if (dst) { *(f32x4*)dst = a; *(f32x4*)(dst + 4) = b; }
    }
};

__device__ __forceinline__ void p2_scans(Ctx& C) {
    LAS float* red = (LAS float*)(C.lds + RING_OFF);
    const int* pt = (const int*)INF(I_PT);
    const int nunits = NB * AH + DB * AH;
    for (int u = C.bid; u < nunits; u += C.G) {
        float v[16]; float tot = 0.f;
        if (u < NB * AH) {
            const int b = u >> 3, h = u & 7; const float* src = (const float*)(C.ws + WS_FA) + ((size_t)b * SEQ + C.tid * 16) * AH + h;
            float* lo_ = C.out + OFF_FP + ((size_t)b * SEQ + C.tid * 16) * AH + h; const float bfh = INF(I_BF)[h];
#pragma unroll
            for (int i = 0; i < 16; ++i) { const float lf = logsigmoidf_(src[(size_t)i * AH] + bfh); lo_[(size_t)i * AH] = lf; tot += lf; v[i] = tot; }
        } else {
            const int db = (u - NB * AH) >> 3, h = u & 7; const int p0 = C.tid * 16; const int pg = pt[db * NPAGES + (p0 >> 7)];
            const float* src = INF(I_CF) + ((size_t)pg * PAGE + (p0 & 127)) * AH + h;
#pragma unroll
            for (int i = 15; i >= 0; --i) { v[i] = tot; tot += src[(size_t)i * AH]; }
        }
        __syncthreads();
        red[C.tid] = tot;
        __syncthreads();
        float pre = 0.f;
        if (u < NB * AH) { for (int i = 0; i < C.tid; ++i) pre += red[i]; }
        else { for (int i = NTHR - 1; i > C.tid; --i) pre += red[i]; }
        float* dst = u < NB * AH ? (float*)(C.ws + WS_CB) + (size_t)u * SEQ + C.tid * 16 : (float*)(C.ws + WS_SB) + (size_t)(u - NB * AH) * PAST + C.tid * 16;
        const float sgn = u < NB * AH ? -LOG2E : LOG2E;
#pragma unroll
        for (int i = 0; i < 16; i += 4) *(f32x4*)(dst + i) = (f32x4){(v[i] + pre) * sgn, (v[i + 1] + pre) * sgn, (v[i + 2] + pre) * sgn, (v[i + 3] + pre) * sgn};
    }
    if (C.bid == C.G - 1) for (int e = C.tid; e < MS * AH; e += NTHR) C.out[OFF_FS + e] = logsigmoidf_(((const float*)(C.ws + WS_FA))[(size_t)MP * AH + e] + INF(I_BF)[e & 7]);
    __syncthreads();
}


namespace att {
using s16x4_ = s16x4;
constexpr int NW = 8, QBLK = 32, QB = 256, KVBLK = 64;
constexpr int NSLOT = 3, SLOTB = 8192;
constexpr int LDS_K = 0, LDS_V = NSLOT * SLOTB, LDS_WS = 2 * NSLOT * SLOTB, LDS_OST = LDS_WS + NW * 64 * 4, LDS_BYTES_ = LDS_OST + NW * 4096;
constexpr int LDS_BIAS = 86016, LDS_TOTAL = LDS_BIAS + SEQ * 4;
static_assert(LDS_TOTAL <= RING_BYTES, "attention LDS");
__device__ __forceinline__ int crow(int r, int hi) { return (r & 3) + 8 * (r >> 2) + 4 * hi; }
#define SBAR() __builtin_amdgcn_sched_barrier(0)
__device__ __forceinline__ void cmask(f32x16& p0, f32x16& p1, int jb, int qrel, int hi) {
    const float NEG = -INFINITY; int kb = 64 * jb + 4 * hi;
#pragma unroll
    for (int r = 0; r < 16; ++r) { int kv = kb + (r & 3) + 8 * (r >> 2); if (kv > qrel) p0[r] = NEG; if (kv + 32 > qrel) p1[r] = NEG; }
}
__device__ __forceinline__ void glds16(const void* gsrc, unsigned lds_dst) { unsigned keep;
    asm volatile("s_mov_b32 %0, m0\n\ts_mov_b32 m0, %2\n\ts_nop 0\n\tglobal_load_lds_dwordx4 %1, off\n\ts_mov_b32 m0, %0" : "=&s"(keep) : "v"(gsrc), "s"(lds_dst) : "memory"); }
typedef float f32x2_t __attribute__((ext_vector_type(2))); typedef __bf16 bf16x2_t __attribute__((ext_vector_type(2)));
__device__ __forceinline__ unsigned cvtpk_s(float lo, float hi) { f32x2_t v = {lo, hi}; bf16x2_t b = __builtin_convertvector(v, bf16x2_t); return __builtin_bit_cast(unsigned, b); }
#define WAIT_BAR(N) asm volatile("s_waitcnt vmcnt(" #N ") lgkmcnt(0)\n\ts_barrier" ::: "memory")
typedef __attribute__((address_space(3))) const char* lds_cptr;
typedef short v4i16_t __attribute__((ext_vector_type(4)));
__device__ __forceinline__ void kload8(bf16x8* kf, lds_cptr kp) {
    kf[0] = *(const LAS bf16x8*)(kp);        kf[1] = *(const LAS bf16x8*)(kp + 512);
    kf[2] = *(const LAS bf16x8*)(kp + 2048); kf[3] = *(const LAS bf16x8*)(kp + 2560);
    kf[4] = *(const LAS bf16x8*)(kp + 4096); kf[5] = *(const LAS bf16x8*)(kp + 4608);
    kf[6] = *(const LAS bf16x8*)(kp + 6144); kf[7] = *(const LAS bf16x8*)(kp + 6656);
}
__device__ __forceinline__ void kload2(bf16x8* kf, lds_cptr kp, int j) { kf[2 * j] = *(const LAS bf16x8*)(kp + j * 2048); kf[2 * j + 1] = *(const LAS bf16x8*)(kp + j * 2048 + 512); }
__device__ __forceinline__ s16x4 vtr(lds_cptr p) { return __builtin_bit_cast(s16x4, __builtin_amdgcn_ds_read_tr16_b64_v4i16((LAS v4i16_t*)p)); }
#define MX3(a, b, c) __builtin_fmaxf(__builtin_fmaxf((a), (b)), (c))
__device__ __forceinline__ float rowmax(const f32x16& p0, const f32x16& p1) {
    float a = MX3(p0[0], p0[1], p1[0]), b = MX3(p0[2], p0[3], p1[1]); a = MX3(a, p1[2], p1[3]);
#pragma unroll
    for (int r = 4; r < 16; r += 4) { a = MX3(a, p0[r], p0[r + 1]); b = MX3(b, p0[r + 2], p0[r + 3]); a = MX3(a, p1[r], p1[r + 1]); b = MX3(b, p1[r + 2], p1[r + 3]); }
    float m = __builtin_fmaxf(a, b); auto rr = __builtin_amdgcn_permlane32_swap(__float_as_uint(m), __float_as_uint(m), false, false);
    return __builtin_fmaxf(__uint_as_float(rr[0]), __uint_as_float(rr[1]));
}
__device__ __forceinline__ void pv(f32x16* o, int vb, bf16x8 pa0, bf16x8 pa1, bf16x8 pa2, bf16x8 pa3) {
#pragma unroll
    for (int d0 = 0; d0 < 2; ++d0) { s16x4 lo[4], hi[4];
#pragma unroll
        for (int ks = 0; ks < 4; ++ks) {
            asm volatile("ds_read_b64_tr_b16 %0,%1 offset:%c2" : "=&v"(lo[ks]) : "v"(vb), "i"(d0 * 4096 + ks * 1024) : "memory");
            asm volatile("ds_read_b64_tr_b16 %0,%1 offset:%c2" : "=&v"(hi[ks]) : "v"(vb), "i"(d0 * 4096 + ks * 1024 + 512) : "memory"); }
        asm volatile("s_waitcnt lgkmcnt(0)" ::: "memory"); SBAR();
#define PK(k) (bf16x8){lo[k][0], lo[k][1], lo[k][2], lo[k][3], hi[k][0], hi[k][1], hi[k][2], hi[k][3]}
        o[d0] = __builtin_amdgcn_mfma_f32_32x32x16_bf16(pa0, PK(0), o[d0], 0, 0, 0);
        o[d0] = __builtin_amdgcn_mfma_f32_32x32x16_bf16(pa1, PK(1), o[d0], 0, 0, 0);
        o[d0] = __builtin_amdgcn_mfma_f32_32x32x16_bf16(pa2, PK(2), o[d0], 0, 0, 0);
        o[d0] = __builtin_amdgcn_mfma_f32_32x32x16_bf16(pa3, PK(3), o[d0], 0, 0, 0);
#undef PK
    }
}
__device__ __forceinline__ void bias_ld(f32x16& c0, f32x16& c1, const LAS float* bl, int t, int hi, int g0, int g1) {
#pragma unroll
    for (int g = 0; g < 4; ++g) { if (g < g0 || g >= g1) continue;
        const f32x4 a = *(const LAS f32x4*)(bl + t * 64 + 8 * g + 4 * hi), b = *(const LAS f32x4*)(bl + t * 64 + 32 + 8 * g + 4 * hi);
        c0[4 * g] = a[0]; c0[4 * g + 1] = a[1]; c0[4 * g + 2] = a[2]; c0[4 * g + 3] = a[3]; c1[4 * g] = b[0]; c1[4 * g + 1] = b[1]; c1[4 * g + 2] = b[2]; c1[4 * g + 3] = b[3]; }
}
template <int THRL> __device__ __forceinline__ void attn_unit(int tid, int b, int h, int qb, const bf16* U, const float* CB, bf16* OA, LAS unsigned char* shmL) {
    char* shm = (char*)shmL;
    const int lane = tid & 63, r32 = lane & 31, hi = lane >> 5; const int wid = __builtin_amdgcn_readfirstlane(tid >> 6);
    const long rowbase = (long)b * SEQ; const int q0 = qb * QB;
    const bf16* Qw = U + (rowbase + q0 + wid * QBLK) * NU + UC_QA + h * 64;
    const bf16* Kh = U + rowbase * NU + UC_KA + h * 64; const bf16* Vh = U + rowbase * NU + UC_VA + h * 64;
    const unsigned lds0 = (unsigned)(uintptr_t)shm;
    LAS float* wsf = (LAS float*)(shmL + LDS_WS) + wid * 64;
    const LAS float* bl = (const LAS float*)(shmL + LDS_BIAS);
    const int NT = (q0 + QB) / KVBLK;
    { const float* CBh = CB + (size_t)(b * AH + h) * SEQ; LAS float* blw = (LAS float*)(shmL + LDS_BIAS);
      for (int e = tid * 4; e < NT * 64; e += NTHR * 4) *(LAS f32x4*)(blw + e) = *(const f32x4*)(CBh + e);
      asm volatile("s_waitcnt vmcnt(0)" ::: "memory"); }
    const bf16* ksrc = Kh + (long)lane * NU + wid * 8;
    const bf16* vsrc = Vh + (long)(16 * (wid & 3) + (lane >> 2)) * NU + (wid >> 2) * 32 + (lane & 3) * 8;
    const unsigned kdst = lds0 + LDS_K + wid * 1024, vdst = lds0 + LDS_V + wid * 1024;
#define DMA_K(t, slot) glds16(ksrc + (long)(t) * KVBLK * NU, (unsigned)__builtin_amdgcn_readfirstlane(kdst + (slot)))
#define DMA_V(t, slot) glds16(vsrc + (long)(t) * KVBLK * NU, (unsigned)__builtin_amdgcn_readfirstlane(vdst + (slot)))
    const int vb0 = (int)(lds0 + LDS_V) + ((lane >> 4) & 1) * 32 + (lane & 3) * 8 + (4 * hi + ((lane & 15) >> 2)) * 64;
    bf16x8 kf[8];
    const lds_cptr shm3 = (lds_cptr)shmL; const lds_cptr kp0 = shm3 + LDS_K + hi * 1024 + r32 * 16; const lds_cptr vp0 = shm3 + LDS_V + ((lane >> 4) & 1) * 32 + (lane & 3) * 8 + (4 * hi + ((lane & 15) >> 2)) * 64;
    DMA_K(0, 0); DMA_V(0, 0); DMA_K(1, SLOTB);
    bf16x8 qr[4];
#pragma unroll
    for (int d0 = 0; d0 < 4; ++d0) qr[d0] = *reinterpret_cast<const bf16x8*>(&Qw[(long)r32 * NU + d0 * 16 + hi * 8]);
    float mhat = 0.f, l_reg = 0.f; f32x16 o[2]; o[0] = f32x16{}; o[1] = f32x16{};
    const int qrel = wid * QBLK + r32;
#define CMASK(P0, P1, t) do { int jb_ = (t) - (NT - 4); if (jb_ >= 0) cmask(P0, P1, jb_, qrel, hi); } while (0)
    bool resc = false;
#define START(P0, P1) do { const float rm = rowmax(P0, P1); resc = false; \
    { const float dl = rm; mhat = mhat + dl; \
      _Pragma("unroll") for (int r = 0; r < 16; ++r) { P0[r] = P0[r] - dl; P1[r] = P1[r] - dl; } } \
    _Pragma("unroll") for (int r = 0; r < 16; ++r) P0[r] = __builtin_amdgcn_exp2f(P0[r]); } while (0)
#define RESC() do { if (resc) { asm volatile("s_waitcnt lgkmcnt(0)" ::: "memory"); \
      _Pragma("unroll") for (int d_ = 0; d_ < 2; ++d_) _Pragma("unroll") for (int r = 0; r < 16; ++r) o[d_][r] *= wsf[crow(r, hi)]; } } while (0)
    f32x16 pA0, pA1, pB0, pB1;
    int sl_prev = 0, sl_cur = 0, sl_next = SLOTB;
#define ROT() do { sl_prev = sl_cur; sl_cur = sl_next; sl_next = (sl_next == (NSLOT - 1) * SLOTB) ? 0 : sl_next + SLOTB; } while (0)
    DMA_K(2, 2 * SLOTB);
    WAIT_BAR(3);
    bias_ld(pA0, pA1, bl, 0, hi, 0, 4);
    { const lds_cptr kb = kp0;
#pragma unroll
      for (int d0 = 0; d0 < 4; ++d0) { const bf16x8 b0 = *(const LAS bf16x8*)(kb + d0 * 2048), b1 = *(const LAS bf16x8*)(kb + d0 * 2048 + 512);
          pA0 = __builtin_amdgcn_mfma_f32_32x32x16_bf16(b0, qr[d0], pA0, 0, 0, 0); pA1 = __builtin_amdgcn_mfma_f32_32x32x16_bf16(b1, qr[d0], pA1, 0, 0, 0); } }
    CMASK(pA0, pA1, 0);
    START(pA0, pA1);
    _Pragma("unroll") for (int r = 0; r < 16; ++r) pA1[r] = __builtin_amdgcn_exp2f(pA1[r]);
    WAIT_BAR(0);
    DMA_K(3, 0); DMA_V(1, SLOTB);
    ROT();
    kload8(kf, kp0 + sl_cur);
    bias_ld(pB0, pB1, bl, 1, hi, 0, 4);
    WAIT_BAR(2);
    s16x4 vlo[8], vhi[8]; v4u pw0, pw1, pw2, pw3;
#define PKW(P, B) cvtpk_s(P[B], P[B + 1])
#define PAF(k) __builtin_bit_cast(bf16x8, pw##k)
#define VFR(i) (bf16x8){vlo[i][0], vlo[i][1], vlo[i][2], vlo[i][3], vhi[i][0], vhi[i][1], vhi[i][2], vhi[i][3]}
#define PIN(x) asm volatile("" : "+v"(x))
#define GAPA(MF, A0, A1, A2, A3, W0, W1, PW) do { MF; sacc += A0; sacc += A1; sacc += A2; sacc += A3; PIN(sacc); W0; W1; PIN(PW); SBAR(); } while (0)
#define EX(v) __builtin_amdgcn_exp2f(v)
#define GAPB(MF, X, B) do { MF; X[B] = EX(X[B]); X[B + 1] = EX(X[B + 1]); X[B + 2] = EX(X[B + 2]); X[B + 3] = EX(X[B + 3]); PIN(X); SBAR(); } while (0)
#define VRD(i) do { vlo[i] = vtr(vp_ + (((i) >> 2) * 4096 + ((i) & 3) * 1024)); vhi[i] = vtr(vp_ + (((i) >> 2) * 4096 + ((i) & 3) * 1024 + 512)); } while (0)
#define KRD(G, j) do { if (G) { kload2(kf, kp0 + sl_next, j); SBAR(); } } while (0)
#define BRD(G, P0, P1, t, g0, g1) do { if (G) { bias_ld(P0, P1, bl, (t) + 1, hi, g0, g1); SBAR(); } } while (0)
#define STEP(C0, C1, P0, P1, t, GK, GV, GL) do { SBAR(); \
    const lds_cptr vp_ = vp0 + sl_prev; \
    { const float nm_ = -mhat; _Pragma("unroll") for (int r = 0; r < 16; ++r) { C0[r] += nm_; C1[r] += nm_; } } \
    VRD(0); SBAR(); float sacc = (P0[0] + P0[1]); \
    GAPA(C0 = __builtin_amdgcn_mfma_f32_32x32x16_bf16(kf[0], qr[0], C0, 0, 0, 0), P0[2], P0[3], P0[4], P0[5],     pw0[0] = PKW(P0, 0), pw0[1] = PKW(P0, 2), pw0); \
    VRD(4); SBAR(); GAPA(C1 = __builtin_amdgcn_mfma_f32_32x32x16_bf16(kf[1], qr[0], C1, 0, 0, 0), P0[6], P0[7], P0[8], P0[9],     pw0[2] = PKW(P0, 4), pw0[3] = PKW(P0, 6), pw0); \
    VRD(1); SBAR(); GAPA(C0 = __builtin_amdgcn_mfma_f32_32x32x16_bf16(kf[2], qr[1], C0, 0, 0, 0),   P0[10], P0[11], P0[12], P0[13], pw1[0] = PKW(P0, 8), pw1[1] = PKW(P0, 10), pw1); \
    VRD(5); SBAR(); GAPA(C1 = __builtin_amdgcn_mfma_f32_32x32x16_bf16(kf[3], qr[1], C1, 0, 0, 0),   P0[14], P0[15], P1[0], P1[1],   pw1[2] = PKW(P0, 12), pw1[3] = PKW(P0, 14), pw1); \
    VRD(2); SBAR(); GAPA(C0 = __builtin_amdgcn_mfma_f32_32x32x16_bf16(kf[4], qr[2], C0, 0, 0, 0),   P1[2], P1[3], P1[4], P1[5],     pw2[0] = PKW(P1, 0), pw2[1] = PKW(P1, 2), pw2); \
    VRD(6); SBAR(); GAPA(C1 = __builtin_amdgcn_mfma_f32_32x32x16_bf16(kf[5], qr[2], C1, 0, 0, 0),   P1[6], P1[7], P1[8], P1[9],     pw2[2] = PKW(P1, 4), pw2[3] = PKW(P1, 6), pw2); \
    VRD(3); SBAR(); GAPA(C0 = __builtin_amdgcn_mfma_f32_32x32x16_bf16(kf[6], qr[3], C0, 0, 0, 0),   P1[10], P1[11], P1[12], P1[13], pw3[0] = PKW(P1, 8), pw3[1] = PKW(P1, 10), pw3); \
    VRD(7); SBAR(); GAPA(C1 = __builtin_amdgcn_mfma_f32_32x32x16_bf16(kf[7], qr[3], C1, 0, 0, 0),   P1[14], P1[15], 0.f, 0.f,       pw3[2] = PKW(P1, 12), pw3[3] = PKW(P1, 14), pw3); \
    l_reg += sacc; \
    if (GK) { DMA_K((t) + 3, sl_cur); } if (GV) { DMA_V((t) + 1, sl_next); } \
    CMASK(C0, C1, t); \
    { float a = MX3(C0[0], C0[1], C1[0]), b = MX3(C0[2], C0[3], C1[1]); a = MX3(a, C1[2], C1[3]); \
      _Pragma("unroll") for (int r = 4; r < 16; r += 4) { a = MX3(a, C0[r], C0[r + 1]); b = MX3(b, C0[r + 2], C0[r + 3]); a = MX3(a, C1[r], C1[r + 1]); b = MX3(b, C1[r + 2], C1[r + 3]); } \
      float rm = __builtin_fmaxf(a, b); { auto rr = __builtin_amdgcn_permlane32_swap(__float_as_uint(rm), __float_as_uint(rm), false, false); rm = __builtin_fmaxf(__uint_as_float(rr[0]), __uint_as_float(rr[1])); } \
      resc = false; \
      if (__builtin_expect(__any(rm > (float)THRL), 0)) { const float dl = __builtin_fmaxf(rm, 0.f); mhat += dl; \
        _Pragma("unroll") for (int r = 0; r < 16; ++r) { C0[r] -= dl; C1[r] -= dl; } \
        const float f = __builtin_amdgcn_exp2f(-dl); l_reg *= f; if (hi == 0) wsf[r32] = f; resc = true; } } \
    SBAR(); \
    GAPB(o[0] = __builtin_amdgcn_mfma_f32_32x32x16_bf16(PAF(0), VFR(0), o[0], 0, 0, 0), C0, 0); \
    BRD(GL, P0, P1, t, 0, 1); GAPB(o[1] = __builtin_amdgcn_mfma_f32_32x32x16_bf16(PAF(0), VFR(4), o[1], 0, 0, 0), C0, 4); \
    KRD(GL, 0); GAPB(o[0] = __builtin_amdgcn_mfma_f32_32x32x16_bf16(PAF(1), VFR(1), o[0], 0, 0, 0), C0, 8); \
    KRD(GL, 1); GAPB(o[1] = __builtin_amdgcn_mfma_f32_32x32x16_bf16(PAF(1), VFR(5), o[1], 0, 0, 0), C0, 12); \
    KRD(GL, 2); GAPB(o[0] = __builtin_amdgcn_mfma_f32_32x32x16_bf16(PAF(2), VFR(2), o[0], 0, 0, 0), C1, 0); \
    KRD(GL, 3); GAPB(o[1] = __builtin_amdgcn_mfma_f32_32x32x16_bf16(PAF(2), VFR(6), o[1], 0, 0, 0), C1, 4); \
    BRD(GL, P0, P1, t, 1, 2); GAPB(o[0] = __builtin_amdgcn_mfma_f32_32x32x16_bf16(PAF(3), VFR(3), o[0], 0, 0, 0), C1, 8); \
    BRD(GL, P0, P1, t, 2, 4); GAPB(o[1] = __builtin_amdgcn_mfma_f32_32x32x16_bf16(PAF(3), VFR(7), o[1], 0, 0, 0), C1, 12); \
    } while (0)
    int t = 1;
#undef CMASK
#define CMASK(P0, P1, t) do { } while (0)
    for (; t + 5 < NT; t += 2) {
        STEP(pB0, pB1, pA0, pA1, t, true, true, true);     WAIT_BAR(2); RESC(); ROT();
        STEP(pA0, pA1, pB0, pB1, t + 1, true, true, true); WAIT_BAR(2); RESC(); ROT();
    }
#undef CMASK
#define CMASK(P0, P1, t) do { int jb_ = (t) - (NT - 4); if (jb_ >= 0) cmask(P0, P1, jb_, qrel, hi); } while (0)
#define ENDW(tt) do { if ((tt) + 3 < NT) { WAIT_BAR(2); } else if ((tt) + 2 < NT) { WAIT_BAR(1); } else { WAIT_BAR(0); } } while (0)
    for (; t + 1 < NT; t += 2) {
        STEP(pB0, pB1, pA0, pA1, t, (t + 3 < NT), (t + 1 < NT), (t + 1 < NT));     ENDW(t);     RESC(); ROT();
        STEP(pA0, pA1, pB0, pB1, t + 1, (t + 4 < NT), (t + 2 < NT), (t + 2 < NT)); ENDW(t + 1); RESC(); ROT();
    }
    STEP(pB0, pB1, pA0, pA1, NT - 1, false, false, false); RESC();
    { float sacc = pB0[0] + pB0[1]; _Pragma("unroll") for (int r = 2; r < 16; ++r) sacc += pB0[r]; _Pragma("unroll") for (int r = 0; r < 16; ++r) sacc += pB1[r]; l_reg += sacc;
      pw0 = (v4u){PKW(pB0, 0), PKW(pB0, 2), PKW(pB0, 4), PKW(pB0, 6)}; pw1 = (v4u){PKW(pB0, 8), PKW(pB0, 10), PKW(pB0, 12), PKW(pB0, 14)}; pw2 = (v4u){PKW(pB1, 0), PKW(pB1, 2), PKW(pB1, 4), PKW(pB1, 6)}; pw3 = (v4u){PKW(pB1, 8), PKW(pB1, 10), PKW(pB1, 12), PKW(pB1, 14)};
      SBAR(); pv(o, vb0 + sl_cur, PAF(0), PAF(1), PAF(2), PAF(3)); }
#undef PKW
#undef PAF
#undef VFR
#undef PIN
#undef GAPA
#undef GAPB
#undef EX
#undef VRD
#undef KRD
#undef BRD
#undef STEP
#undef ENDW
    { auto rr = __builtin_amdgcn_permlane32_swap(__float_as_uint(l_reg), __float_as_uint(l_reg), false, false); l_reg = __uint_as_float(rr[0]) + __uint_as_float(rr[1]); }
    if (hi == 0) wsf[32 + r32] = l_reg; asm volatile("s_waitcnt lgkmcnt(0)" ::: "memory");
    float rli[16];
#pragma unroll
    for (int r = 0; r < 16; ++r) rli[r] = __builtin_amdgcn_rcpf(wsf[32 + crow(r, hi)]);
    bf16* Ow = OA + (rowbase + q0 + wid * QBLK) * AW + h * 64;
    { LAS bf16* stg = (LAS bf16*)(shmL + LDS_OST) + wid * 2048;
#pragma unroll
      for (int r = 0; r < 16; ++r) { const int orow = crow(r, hi);
#pragma unroll
          for (int d0 = 0; d0 < 2; ++d0) stg[orow * 64 + d0 * 32 + r32] = (bf16)(cvtpk_s(o[d0][r] * rli[r], 0.f) & 0xffffu); }
      asm volatile("s_waitcnt lgkmcnt(0)" ::: "memory");
#pragma unroll
      for (int i = 0; i < 4; ++i) { const int row = i * 8 + (lane >> 3), ch = lane & 7; const v4u v = *(const LAS v4u*)(stg + row * 64 + ch * 8); *(v4u*)(Ow + (long)row * AW + ch * 8) = v; } }
    asm volatile("s_waitcnt vmcnt(0) lgkmcnt(0)\n\ts_barrier" ::: "memory");
#undef DMA_K
#undef DMA_V
#undef CMASK
#undef START
#undef RESC
#undef ROT
}
#undef SBAR
#undef WAIT_BAR
#undef MX3
}

struct SaBlk { f32x4 kk[4], vv[4], sb; };
__device__ __forceinline__ void sa_load(SaBlk& B, const float* Kb, const float* Vb, const float* SBp, int q, int fq) {
#pragma unroll
    for (int m = 0; m < 4; ++m) B.kk[m] = *(const f32x4*)(Kb + (size_t)q * AW + (4 * m + fq) * 4);
#pragma unroll
    for (int r4 = 0; r4 < 4; ++r4) B.vv[r4] = *(const f32x4*)(Vb + (size_t)(4 * fq + r4) * AW + q * 4);
    B.sb = *(const f32x4*)(SBp + 4 * fq);
}
__device__ __forceinline__ void sa_compute(const SaBlk& B, const float (&qf)[4][4], float& mrun, float& lsum, f32x4 (&o)[4]) {
    f32x4 s = B.sb;
#pragma unroll
    for (int m = 0; m < 4; ++m)
#pragma unroll
        for (int j = 0; j < 4; ++j) s = __builtin_amdgcn_mfma_f32_16x16x4f32(B.kk[m][j], qf[m][j], s, 0, 0, 0);
    float rm = fmaxf(fmaxf(s[0], s[1]), fmaxf(s[2], s[3]));
    rm = fmaxf(rm, __shfl_xor(rm, 16)); rm = fmaxf(rm, __shfl_xor(rm, 32));
    const float mn = fmaxf(mrun, rm); const float f = __builtin_amdgcn_exp2f(mrun - mn); mrun = mn;
    f32x4 p;
#pragma unroll
    for (int i = 0; i < 4; ++i) p[i] = __builtin_amdgcn_exp2f(s[i] - mn);
    lsum = lsum * f + (p[0] + p[1]) + (p[2] + p[3]);
#pragma unroll
    for (int j = 0; j < 4; ++j) o[j] = o[j] * f;
#pragma unroll
    for (int r4 = 0; r4 < 4; ++r4)
#pragma unroll
        for (int j = 0; j < 4; ++j) o[j] = __builtin_amdgcn_mfma_f32_16x16x4f32(B.vv[r4][j], p[r4], o[j], 0, 0, 0);
}
__device__ __forceinline__ void sattn_unit(Ctx& C, int db, int rg) {
    const int lane = C.lane, h = C.wave, q = lane & 15, fq = lane >> 4;
    const bf16* U = (const bf16*)(C.ws + WS_U);
    const int* pt = (const int*)INF(I_PT);
    const float* SBh = (const float*)(C.ws + WS_SB) + (size_t)(db * AH + h) * PAST + rg * 1024;
    const float* CK = INF(I_CK) + h * 64; const float* CV = INF(I_CV) + h * 64;
    const int pgv = pt[db * NPAGES + rg * 8 + (lane & 7)];
    float qf[4][4];
    { const bf16* qrow = U + (size_t)(MP + db * DS + (q & 7)) * NU + UC_QA + h * 64;
#pragma unroll
      for (int m = 0; m < 4; ++m) { const v2u w = *(const v2u*)(qrow + (4 * m + fq) * 4);
          qf[m][0] = q < 8 ? bflo(w.x) : 0.f; qf[m][1] = q < 8 ? bfhi(w.x) : 0.f; qf[m][2] = q < 8 ? bflo(w.y) : 0.f; qf[m][3] = q < 8 ? bfhi(w.y) : 0.f; } }
    float mrun = -INFINITY, lsum = 0.f; f32x4 o[4];
#pragma unroll
    for (int j = 0; j < 4; ++j) o[j] = (f32x4){0.f, 0.f, 0.f, 0.f};
#define SA_TOK(b) ((size_t)__builtin_amdgcn_readlane(pgv, (b) >> 3) * PAGE + ((b) & 7) * 16)
    SaBlk A, B;
    __builtin_amdgcn_sched_barrier(0);
    { const size_t t0 = SA_TOK(0) * AW; sa_load(A, CK + t0, CV + t0, SBh, q, fq); }
    __builtin_amdgcn_sched_barrier(0);
    { const size_t t1 = SA_TOK(1) * AW; sa_load(B, CK + t1, CV + t1, SBh + 16, q, fq); }
    __builtin_amdgcn_sched_barrier(0);
#pragma unroll 1
    for (int blk = 0; blk < 64; blk += 2) {
        sa_compute(A, qf, mrun, lsum, o); __builtin_amdgcn_sched_barrier(0);
        { const int bn = (blk + 2 < 64) ? blk + 2 : 63; const size_t t = SA_TOK(bn) * AW; sa_load(A, CK + t, CV + t, SBh + bn * 16, q, fq); }
        __builtin_amdgcn_sched_barrier(0);
        sa_compute(B, qf, mrun, lsum, o); __builtin_amdgcn_sched_barrier(0);
        { const int bn = (blk + 3 < 64) ? blk + 3 : 63; const size_t t = SA_TOK(bn) * AW; sa_load(B, CK + t, CV + t, SBh + bn * 16, q, fq); }
        __builtin_amdgcn_sched_barrier(0);
    }
#undef SA_TOK
    lsum += __shfl_xor(lsum, 16); lsum += __shfl_xor(lsum, 32);
    if (q < 8) {
        float* dst = (float*)(C.ws + WS_PART) + ((size_t)((db * 8 + rg) * AH + h) * DS + q) * PART_STRIDE;
        if (fq == 0) { dst[0] = mrun; dst[1] = lsum; }
#pragma unroll
        for (int j = 0; j < 4; ++j)
#pragma unroll
            for (int r = 0; r < 4; ++r) dst[4 + 4 * (4 * fq + r) + j] = o[j][r];
    }
}
__device__ __forceinline__ void sattn_combine(Ctx& C) {
    const bf16* U = (const bf16*)(C.ws + WS_U); bf16* OA = (bf16*)(C.ws + WS_OA);
    const int gw = C.bid * NWAVES + C.wave, NGW = C.G * NWAVES, d = C.lane;
    for (int it = gw; it < DB * AH * DS; it += NGW) {
        const int db = it >> 6, h = (it >> 3) & 7, q = it & 7;
        const float qd = bf2f(U[(size_t)(MP + db * DS + q) * NU + UC_QA + h * 64 + d]);
        float sn[8]; float cn = 0.f; float M = -INFINITY;
#pragma unroll
        for (int j = 0; j < 8; ++j) {
            cn += C.out[OFF_FS + (size_t)(db * DS + j) * AH + h];
            const float kd = C.out[OFF_KS + (size_t)(db * DS + j) * AW + h * 64 + d];
            const float s = wave_sum(qd * kd) - cn * LOG2E;
            sn[j] = j <= q ? s : -INFINITY; M = fmaxf(M, sn[j]);
        }
        float pm[8], pl[8];
#pragma unroll
        for (int r = 0; r < 8; ++r) { const float* src = (const float*)(C.ws + WS_PART) + ((size_t)((db * 8 + r) * AH + h) * DS + q) * PART_STRIDE; pm[r] = src[0]; pl[r] = src[1]; M = fmaxf(M, pm[r]); }
        float L = 0.f, O = 0.f;
#pragma unroll
        for (int r = 0; r < 8; ++r) { const float* src = (const float*)(C.ws + WS_PART) + ((size_t)((db * 8 + r) * AH + h) * DS + q) * PART_STRIDE; const float w = __builtin_amdgcn_exp2f(pm[r] - M); L += pl[r] * w; O += src[4 + d] * w; }
#pragma unroll
        for (int j = 0; j < 8; ++j) { const float w = __builtin_amdgcn_exp2f(sn[j] - M); L += w; O += w * C.out[OFF_VS + (size_t)(db * DS + j) * AW + h * 64 + d]; }
        OA[(size_t)(MP + db * DS + q) * AW + h * 64 + d] = (bf16)f2bf(O / L);
    }
}


namespace gla {
constexpr int QSTR = 136, TSTR = 72;
constexpr int L_ALB = 0, L_W2 = 4096, L_BA = 12288, L_PRE = 12800, L_D = 14848, L_QS = 15360, L_KS = 32768, L_KLT = 50176, L_VT = 68608, L_BC = 105472, L_END = 138240;
__device__ __forceinline__ int perm16(int x) { return (x & ~15) | (((x >> 2) & 1) << 3) | (((x >> 3) & 1) << 2) | (x & 3); }
__device__ __forceinline__ int crow(int r, int hi) { return (r & 3) + 8 * (r >> 2) + 4 * hi; }
typedef float f32x2_t __attribute__((ext_vector_type(2))); typedef __bf16 bf16x2_t __attribute__((ext_vector_type(2)));
__device__ __forceinline__ unsigned cvtv(float lo, float hi) { f32x2_t v = {lo, hi}; bf16x2_t b = __builtin_convertvector(v, bf16x2_t); return __builtin_bit_cast(unsigned, b); }
__device__ __forceinline__ bf16x8 packacc(const f32x16& a, int s) {
    v4u w;
    if (s == 0) { w.x = cvtv(a[0], a[1]); w.y = cvtv(a[2], a[3]); w.z = cvtv(a[4], a[5]); w.w = cvtv(a[6], a[7]); }
    else        { w.x = cvtv(a[8], a[9]); w.y = cvtv(a[10], a[11]); w.z = cvtv(a[12], a[13]); w.w = cvtv(a[14], a[15]); }
    return __builtin_bit_cast(bf16x8, w);
}
__device__ __forceinline__ void load_head(Ctx& C, int h) {
    LAS float* W2 = (LAS float*)(C.lds + L_W2); LAS float* BA = (LAS float*)(C.lds + L_BA);
    __syncthreads();
    for (int e = C.tid; e < 2048; e += NTHR) W2[e] = INF(I_WA2)[(e >> 7) * BKW + h * 128 + (e & 127)];
    if (C.tid < 128) BA[C.tid] = INF(I_BA)[h * 128 + C.tid];
}
template <bool NEED_QK> __device__ __forceinline__ void stage_chunk(Ctx& C, int row_c0, int nvalid, int h) {
    const bf16* U = (const bf16*)(C.ws + WS_U); const float* alow = (const float*)(C.ws + WS_ALOW);
    LAS float* ALB = (LAS float*)(C.lds + L_ALB); LAS float* W2 = (LAS float*)(C.lds + L_W2); LAS float* BA = (LAS float*)(C.lds + L_BA);
    LAS float* PRE = (LAS float*)(C.lds + L_PRE); LAS float* Dv = (LAS float*)(C.lds + L_D); LAS float* BC = (LAS float*)(C.lds + L_BC);
    LAS bf16* QS = (LAS bf16*)(C.lds + L_QS); LAS bf16* KS = (LAS bf16*)(C.lds + L_KS); LAS bf16* KLT = (LAS bf16*)(C.lds + L_KLT); LAS bf16* VT = (LAS bf16*)(C.lds + L_VT);
    const int tid = C.tid, i = tid & 127, tq = tid >> 7;
    __syncthreads();
#pragma unroll
    for (int n = 0; n < 2; ++n) { const int e = tid + NTHR * n; ALB[e] = (e >> 4) < nvalid ? alow[(size_t)row_c0 * GR + e] : 0.f; }
#pragma unroll
    for (int n = 0; n < 4; ++n) { const int e = tid + NTHR * n, t = e & 63, vg = e >> 6;
        v4u w = (v4u){0u, 0u, 0u, 0u};
        if (t < nvalid) w = *(const v4u*)(U + (size_t)(row_c0 + t) * NU + UC_VB + h * 256 + vg * 8);
        LAS bf16* d = VT + (vg * 8) * TSTR + perm16(t);
        d[0] = (bf16)(w.x & 0xffffu); d[TSTR] = (bf16)(w.x >> 16); d[2 * TSTR] = (bf16)(w.y & 0xffffu); d[3 * TSTR] = (bf16)(w.y >> 16);
        d[4 * TSTR] = (bf16)(w.z & 0xffffu); d[5 * TSTR] = (bf16)(w.z >> 16); d[6 * TSTR] = (bf16)(w.w & 0xffffu); d[7 * TSTR] = (bf16)(w.w >> 16); }
    __syncthreads();
    {
        float w2[16];
#pragma unroll
        for (int r = 0; r < 16; ++r) w2[r] = W2[r * 128 + i];
        const float ba = BA[i]; float run = 0.f;
#pragma unroll 4
        for (int tt = 0; tt < 16; ++tt) { const int t = 16 * tq + tt; float x = ba;
            const f32x4 a0 = *(const LAS f32x4*)(ALB + t * 16), a1 = *(const LAS f32x4*)(ALB + t * 16 + 4), a2 = *(const LAS f32x4*)(ALB + t * 16 + 8), a3 = *(const LAS f32x4*)(ALB + t * 16 + 12);
            x += a0[0] * w2[0] + a0[1] * w2[1] + a0[2] * w2[2] + a0[3] * w2[3]; x += a1[0] * w2[4] + a1[1] * w2[5] + a1[2] * w2[6] + a1[3] * w2[7];
            x += a2[0] * w2[8] + a2[1] * w2[9] + a2[2] * w2[10] + a2[3] * w2[11]; x += a3[0] * w2[12] + a3[1] * w2[13] + a3[2] * w2[14] + a3[3] * w2[15];
            const float la = (fminf(x, 0.f) - __logf(1.f + __expf(-fabsf(x)))) * (1.f / 16.f);
            run += (t < nvalid) ? la : 0.f; BC[t * 128 + i] = run; }
        PRE[tq * 128 + i] = run;
    }
    __syncthreads();
    {
        const float p0 = PRE[i], p1 = PRE[128 + i], p2 = PRE[256 + i], p3 = PRE[384 + i];
        const float tot = (p0 + p1) + (p2 + p3);
        if (tq == 0) Dv[i] = __expf(tot);
        const int pi = perm16(i);
#pragma unroll 4
        for (int n = 0; n < 16; ++n) { const int t = tq + 4 * n; const int q4 = n >> 2;
            const float pre = q4 == 0 ? 0.f : (q4 == 1 ? p0 : (q4 == 2 ? p0 + p1 : p0 + p1 + p2));
            const float B = BC[t * 128 + i] + pre;
            const size_t ro = (size_t)(row_c0 + t) * NU;
            const float kv = t < nvalid ? bf2f(U[ro + UC_KB + h * 128 + i]) : 0.f;
            KLT[i * TSTR + perm16(t)] = (bf16)f2bf(kv * __expf(tot - B));
            if (NEED_QK) { const float qv = t < nvalid ? bf2f(U[ro + UC_QB + h * 128 + i]) : 0.f; const float e1 = __expf(B);
                QS[t * QSTR + pi] = (bf16)f2bf(qv * e1); KS[t * QSTR + pi] = (bf16)f2bf(kv * __expf(-B)); } }
    }
    __syncthreads();
}
template <bool OUT, bool UPD> __device__ __forceinline__ void mma_chunk(Ctx& C, f32x16 (&acc)[4], int row_c0, int nvalid, int h) {
    const int lane = C.lane, w = C.wave, r32 = lane & 31, hi = lane >> 5;
    const LAS bf16* QS = (const LAS bf16*)(C.lds + L_QS); const LAS bf16* KS = (const LAS bf16*)(C.lds + L_KS);
    const LAS bf16* KLT = (const LAS bf16*)(C.lds + L_KLT); const LAS bf16* VT = (const LAS bf16*)(C.lds + L_VT); const LAS float* Dv = (const LAS float*)(C.lds + L_D);
    bf16x8 vt[4];
#pragma unroll
    for (int ks = 0; ks < 4; ++ks) vt[ks] = *(const LAS bf16x8*)(VT + (32 * w + r32) * TSTR + 16 * ks + 8 * hi);
    if (OUT) {
        char* OBRb = (char*)((float*)(C.ws + WS_OBR) + (size_t)row_c0 * BVW + h * 256 + 32 * w);
        const unsigned ovoff = (unsigned)((4 * hi) * BVW + r32) * 4u;
        f32x16 o0 = f32x16{}, o1 = f32x16{};
#pragma unroll
        for (int rt = 0; rt < 4; ++rt)
#pragma unroll
            for (int s = 0; s < 2; ++s) { const bf16x8 bfr = packacc(acc[rt], s);
                const bf16x8 a0 = *(const LAS bf16x8*)(QS + r32 * QSTR + 32 * rt + 16 * s + 8 * hi), a1 = *(const LAS bf16x8*)(QS + (32 + r32) * QSTR + 32 * rt + 16 * s + 8 * hi);
                o0 = __builtin_amdgcn_mfma_f32_32x32x16_bf16(a0, bfr, o0, 0, 0, 0); o1 = __builtin_amdgcn_mfma_f32_32x32x16_bf16(a1, bfr, o1, 0, 0, 0); }
        __builtin_amdgcn_sched_barrier(0);
        {
            f32x16 X = f32x16{};
#pragma unroll
            for (int kk = 0; kk < 8; ++kk) { const bf16x8 k0 = *(const LAS bf16x8*)(KS + r32 * QSTR + 16 * kk + 8 * hi), q0 = *(const LAS bf16x8*)(QS + r32 * QSTR + 16 * kk + 8 * hi);
                X = __builtin_amdgcn_mfma_f32_32x32x16_bf16(k0, q0, X, 0, 0, 0); }
#pragma unroll
            for (int r = 0; r < 16; ++r) { if (crow(r, hi) > r32) X[r] = 0.f; }
            o0 = __builtin_amdgcn_mfma_f32_32x32x16_bf16(packacc(X, 0), vt[0], o0, 0, 0, 0); o0 = __builtin_amdgcn_mfma_f32_32x32x16_bf16(packacc(X, 1), vt[1], o0, 0, 0, 0);
#pragma unroll
            for (int r = 0; r < 16; ++r) { const int tu = (r & 3) + 8 * (r >> 2); if (tu + 4 * hi < nvalid) *(float*)(OBRb + (size_t)tu * BVW * 4 + ovoff) = o0[r]; }
        }
        __builtin_amdgcn_sched_barrier(0);
        if (nvalid > 32) {
            f32x16 X01 = f32x16{}, X11 = f32x16{};
#pragma unroll
            for (int kk = 0; kk < 8; ++kk) {
                const bf16x8 k0 = *(const LAS bf16x8*)(KS + r32 * QSTR + 16 * kk + 8 * hi), k1 = *(const LAS bf16x8*)(KS + (32 + r32) * QSTR + 16 * kk + 8 * hi);
                const bf16x8 q1 = *(const LAS bf16x8*)(QS + (32 + r32) * QSTR + 16 * kk + 8 * hi);
                X01 = __builtin_amdgcn_mfma_f32_32x32x16_bf16(k0, q1, X01, 0, 0, 0); X11 = __builtin_amdgcn_mfma_f32_32x32x16_bf16(k1, q1, X11, 0, 0, 0); }
#pragma unroll
            for (int r = 0; r < 16; ++r) { if (crow(r, hi) > r32) X11[r] = 0.f; }
            o1 = __builtin_amdgcn_mfma_f32_32x32x16_bf16(packacc(X01, 0), vt[0], o1, 0, 0, 0); o1 = __builtin_amdgcn_mfma_f32_32x32x16_bf16(packacc(X01, 1), vt[1], o1, 0, 0, 0);
            o1 = __builtin_amdgcn_mfma_f32_32x32x16_bf16(packacc(X11, 0), vt[2], o1, 0, 0, 0); o1 = __builtin_amdgcn_mfma_f32_32x32x16_bf16(packacc(X11, 1), vt[3], o1, 0, 0, 0);
#pragma unroll
            for (int r = 0; r < 16; ++r) { const int tu = 32 + (r & 3) + 8 * (r >> 2); if (tu + 4 * hi < nvalid) *(float*)(OBRb + (size_t)tu * BVW * 4 + ovoff) = o1[r]; }
        }
    }
    __builtin_amdgcn_sched_barrier(0);
    if (UPD) {
#pragma unroll
        for (int rt = 0; rt < 4; ++rt) {
            __builtin_amdgcn_sched_barrier(0);
#pragma unroll
            for (int r = 0; r < 16; ++r) acc[rt][r] *= Dv[32 * rt + crow(r, hi)];
#pragma unroll
            for (int ks = 0; ks < 4; ++ks) { const bf16x8 a = *(const LAS bf16x8*)(KLT + (32 * rt + r32) * TSTR + 16 * ks + 8 * hi); acc[rt] = __builtin_amdgcn_mfma_f32_32x32x16_bf16(a, vt[ks], acc[rt], 0, 0, 0); }
        }
    }
}
__device__ __forceinline__ void load_state(f32x16 (&acc)[4], const float* S, int w, int r32, int hi) {
    const unsigned voff = (unsigned)((4 * hi) * BV + 32 * w + r32) * 4u;
#pragma unroll
    for (int rt = 0; rt < 4; ++rt) {
#pragma unroll
        for (int g = 0; g < 4; ++g) { const char* sb = (const char*)S + (size_t)(32 * rt + 8 * g) * BV * 4;
#pragma unroll
            for (int j = 0; j < 4; ++j) acc[rt][4 * g + j] = *(const float*)(sb + voff + j * BV * 4); }
        asm volatile("" ::: "memory");
    }
}
__device__ __forceinline__ void store_state(const f32x16 (&acc)[4], float* S, int w, int r32, int hi) {
    const unsigned voff = (unsigned)((4 * hi) * BV + 32 * w + r32) * 4u;
#pragma unroll
    for (int rt = 0; rt < 4; ++rt) {
#pragma unroll
        for (int g = 0; g < 4; ++g) { char* sb = (char*)S + (size_t)(32 * rt + 8 * g) * BV * 4;
#pragma unroll
            for (int j = 0; j < 4; ++j) *(float*)(sb + voff + j * BV * 4) = acc[rt][4 * g + j]; }
        asm volatile("" ::: "memory");
    }
}
__device__ __forceinline__ void b1_unit(Ctx& C, int u) {
    const int sc = u & 31, bh = u >> 5, h = bh & 3, b = bh >> 2; const int row0 = b * SEQ + sc * 256;
    const int r32 = C.lane & 31, hi = C.lane >> 5;
    load_head(C, h);
    f32x16 acc[4]; acc[0] = f32x16{}; acc[1] = f32x16{}; acc[2] = f32x16{}; acc[3] = f32x16{};
    float dprod = 1.f;
#pragma unroll 1
    for (int c = 0; c < 4; ++c) { stage_chunk<false>(C, row0 + 64 * c, 64, h); if (C.tid < 128) dprod *= ((const LAS float*)(C.lds + L_D))[C.tid]; mma_chunk<false, true>(C, acc, row0 + 64 * c, 64, h); }
    store_state(acc, (float*)(C.ws + WS_LS) + (size_t)u * BK_ * BV, C.wave, r32, hi);
    if (C.tid < 128) ((float*)(C.ws + WS_DSC))[u * 128 + C.tid] = dprod;
}
__device__ __forceinline__ void b2_scan(Ctx& C) {
    float* LS = (float*)(C.ws + WS_LS); const float* DSC = (const float*)(C.ws + WS_DSC);
    for (int q = C.bid * NTHR + C.tid; q < NB * BH * BK_ * BV / 4; q += C.G * NTHR) {
        const int bh = q >> 13, rem = q & 8191, i = rem >> 6, v4 = (rem & 63) * 4;
        f32x4 s = (f32x4){0.f, 0.f, 0.f, 0.f};
#pragma unroll 4
        for (int sc = 0; sc < 32; ++sc) { const int u = bh * 32 + sc; f32x4* p = (f32x4*)(LS + ((size_t)u * BK_ + i) * BV + v4); const float d = DSC[u * 128 + i]; s = s * d + *p; *p = s; }
        *(f32x4*)(C.out + OFF_GP + ((size_t)bh * BK_ + i) * BV + v4) = s;
    }
}
__device__ __forceinline__ void b3_unit(Ctx& C, int u) {
    const int sc = u & 31, bh = u >> 5, h = bh & 3, b = bh >> 2; const int row0 = b * SEQ + sc * 256;
    const int r32 = C.lane & 31, hi = C.lane >> 5;
    load_head(C, h);
    f32x16 acc[4];
    if (sc == 0) { acc[0] = f32x16{}; acc[1] = f32x16{}; acc[2] = f32x16{}; acc[3] = f32x16{}; }
    else load_state(acc, (const float*)(C.ws + WS_LS) + (size_t)(u - 1) * BK_ * BV, C.wave, r32, hi);
#pragma unroll 1
    for (int c = 0; c < 4; ++c) { stage_chunk<true>(C, row0 + 64 * c, 64, h); mma_chunk<true, true>(C, acc, row0 + 64 * c, 64, h); }
}
__device__ __forceinline__ void sample_unit(Ctx& C, int u) {
    const int h = u & 3, db = u >> 2; const int row0 = MP + db * DS;
    const int r32 = C.lane & 31, hi = C.lane >> 5;
    load_head(C, h);
    f32x16 acc[4];
    load_state(acc, INF(I_SG) + (size_t)u * BK_ * BV, C.wave, r32, hi);
    stage_chunk<true>(C, row0, DS, h); mma_chunk<true, true>(C, acc, row0, DS, h);
    store_state(acc, C.out + OFF_GS + (size_t)u * BK_ * BV, C.wave, r32, hi);
}
}
__device__ __forceinline__ void gla_post(Ctx& C) {
    const bf16* U = (const bf16*)(C.ws + WS_U); const float* OBR = (const float*)(C.ws + WS_OBR); bf16* OB = (bf16*)(C.ws + WS_OB);
    const int gw = C.bid * NWAVES + C.wave, NGW = C.G * NWAVES;
    const f32x4 gg = *(const f32x4*)(INF(I_GGLA) + C.lane * 4);
    for (int m0 = gw * 2; m0 < MT; m0 += NGW * 2) {
        f32x4 x[2][4]; v2u rb[2][4];
#pragma unroll
        for (int rr = 0; rr < 2; ++rr)
#pragma unroll
            for (int h = 0; h < 4; ++h) { x[rr][h] = *(const f32x4*)(OBR + (size_t)(m0 + rr) * BVW + h * 256 + C.lane * 4); rb[rr][h] = *(const v2u*)(U + (size_t)(m0 + rr) * NU + UC_RB + h * 256 + C.lane * 4); }
#pragma unroll
        for (int rr = 0; rr < 2; ++rr)
#pragma unroll
            for (int h = 0; h < 4; ++h) { const f32x4 xv = x[rr][h];
                const float r = 1.f / sqrtf(wave_sum((xv[0] * xv[0] + xv[1] * xv[1]) + (xv[2] * xv[2] + xv[3] * xv[3])) * (1.f / 256.f) + EPS);
                const float r0 = bflo(rb[rr][h].x), r1 = bfhi(rb[rr][h].x), r2 = bflo(rb[rr][h].y), r3 = bfhi(rb[rr][h].y);
                v2u w; w.x = pk2(xv[0] * r * gg[0] * r0 * sigmoidf_(r0), xv[1] * r * gg[1] * r1 * sigmoidf_(r1)); w.y = pk2(xv[2] * r * gg[2] * r2 * sigmoidf_(r2), xv[3] * r * gg[3] * r3 * sigmoidf_(r3));
                *(v2u*)(OB + (size_t)(m0 + rr) * BVW + h * 256 + C.lane * 4) = w; }
    }
}

__device__ __forceinline__ void p7_rows(Ctx& C) {
    const float* F1 = (const float*)(C.ws + WS_F1); float* X1 = (float*)(C.ws + WS_X1); bf16* XN2 = (bf16*)(C.ws + WS_XN2);
    const int gw = C.bid * NWAVES + C.wave, NGW = C.G * NWAVES, lane = C.lane;
    for (int m0 = gw * 2; m0 < MT; m0 += NGW * 2) {
        f32x4 f[2][4], x[2][4];
#pragma unroll
        for (int rr = 0; rr < 2; ++rr) { const int m = m0 + rr; const float* xr = m < MP ? INF(I_XP) + (size_t)m * DM : INF(I_XS) + (size_t)(m - MP) * DM;
#pragma unroll
            for (int j = 0; j < 4; ++j) { f[rr][j] = *((const f32x4*)(F1 + (size_t)m * DM) + lane + 64 * j); x[rr][j] = *((const f32x4*)xr + lane + 64 * j); } }
#pragma unroll
        for (int rr = 0; rr < 2; ++rr) { const int m = m0 + rr; float s = 0.f;
#pragma unroll
            for (int j = 0; j < 4; ++j) s += (f[rr][j].x * f[rr][j].x + f[rr][j].y * f[rr][j].y) + (f[rr][j].z * f[rr][j].z + f[rr][j].w * f[rr][j].w);
            const float r = 1.f / sqrtf(wave_sum(s) * (1.f / DM) + EPS); float s2 = 0.f;
#pragma unroll
            for (int j = 0; j < 4; ++j) { const f32x4 g = *((const f32x4*)INF(I_GPOM) + lane + 64 * j); x[rr][j] = x[rr][j] + f[rr][j] * r * g; s2 += (x[rr][j].x * x[rr][j].x + x[rr][j].y * x[rr][j].y) + (x[rr][j].z * x[rr][j].z + x[rr][j].w * x[rr][j].w);
                *((f32x4*)(X1 + (size_t)m * DM) + lane + 64 * j) = x[rr][j]; }
            const float r2 = 1.f / sqrtf(wave_sum(s2) * (1.f / DM) + EPS);
#pragma unroll
            for (int j = 0; j < 4; ++j) { const f32x4 g = *((const f32x4*)INF(I_GPF) + lane + 64 * j); v2u w; w.x = pk2(x[rr][j].x * r2 * g.x, x[rr][j].y * r2 * g.y); w.y = pk2(x[rr][j].z * r2 * g.z, x[rr][j].w * r2 * g.w);
                *((v2u*)(XN2 + (size_t)m * DM) + lane + 64 * j) = w; } }
    }
}
__device__ __forceinline__ void p11_rows(Ctx& C) {
    const float* F2 = (const float*)(C.ws + WS_F2); const float* X1 = (const float*)(C.ws + WS_X1);
    const int gw = C.bid * NWAVES + C.wave, NGW = C.G * NWAVES, lane = C.lane;
    for (int m0 = gw * 2; m0 < MT; m0 += NGW * 2) {
        f32x4 f[2][4], x[2][4];
#pragma unroll
        for (int rr = 0; rr < 2; ++rr)
#pragma unroll
            for (int j = 0; j < 4; ++j) { f[rr][j] = *((const f32x4*)(F2 + (size_t)(m0 + rr) * DM) + lane + 64 * j); x[rr][j] = *((const f32x4*)(X1 + (size_t)(m0 + rr) * DM) + lane + 64 * j); }
#pragma unroll
        for (int rr = 0; rr < 2; ++rr) { float s = 0.f;
#pragma unroll
            for (int j = 0; j < 4; ++j) s += (f[rr][j].x * f[rr][j].x + f[rr][j].y * f[rr][j].y) + (f[rr][j].z * f[rr][j].z + f[rr][j].w * f[rr][j].w);
            const float r = 1.f / sqrtf(wave_sum(s) * (1.f / DM) + EPS);
#pragma unroll
            for (int j = 0; j < 4; ++j) { const f32x4 g = *((const f32x4*)INF(I_GPOF) + lane + 64 * j);
                *((f32x4*)(C.out + OFF_YP + (size_t)(m0 + rr) * DM) + lane + 64 * j) = x[rr][j] + f[rr][j] * r * g; } }
    }
}
__device__ __forceinline__ float gelu_tanh(float g) { const float u = 0.7978845608028654f * (g + 0.044715f * g * g * g); const float e = __expf(2.f * u); const float th = 1.f - 2.f / (e + 1.f); return 0.5f * g * (1.f + th); }
__device__ __forceinline__ void unpack8(v4u w, float (&x)[8]) { x[0] = bflo(w.x); x[1] = bfhi(w.x); x[2] = bflo(w.y); x[3] = bfhi(w.y); x[4] = bflo(w.z); x[5] = bfhi(w.z); x[6] = bflo(w.w); x[7] = bfhi(w.w); }
constexpr int CONV_RB = 45;
__device__ __forceinline__ void p9_conv(Ctx& C) {
    const bf16* UU = (const bf16*)(C.ws + WS_UU); bf16* ACT = (bf16*)(C.ws + WS_ACT);
    const float* wc = INF(I_WCONV); const float* bc = INF(I_BCONV);
    constexpr int NG = DFF / 8, NBLK = (MT + CONV_RB - 1) / CONV_RB;
    for (int it = C.bid * NTHR + C.tid; it < NBLK * NG; it += C.G * NTHR) {
        const int blk = it / NG, j0 = (it - blk * NG) * 8; const int r0 = blk * CONV_RB, r1 = (r0 + CONV_RB) < MT ? (r0 + CONV_RB) : MT;
        float w0[2][8], w1[2][8], w2[2][8], bb[2][8];
#pragma unroll
        for (int hf = 0; hf < 2; ++hf)
#pragma unroll
            for (int i = 0; i < 8; ++i) { const int c = hf * DFF + j0 + i; w0[hf][i] = wc[c]; w1[hf][i] = wc[DFF2 + c]; w2[hf][i] = wc[2 * DFF2 + c]; bb[hf][i] = bc[c]; }
        float xa[2][8], xb[2][8];
        auto load_row = [&](int m, float (&o)[2][8]) {
            const v4u a = *(const v4u*)(UU + (size_t)m * DFF2 + j0), g = *(const v4u*)(UU + (size_t)m * DFF2 + DFF + j0); unpack8(a, o[0]); unpack8(g, o[1]); };
        auto load_hist = [&](int m, int back, float (&o)[2][8]) {
            const int t = m < MP ? (m & (SEQ - 1)) : ((m - MP) & 7);
            if (t - back >= 0) load_row(m - back, o);
            else if (m >= MP) { const float* sc = INF(I_SC) + ((size_t)((m - MP) >> 3) * 2 + (t - back + 2)) * DFF2;
#pragma unroll
                for (int i = 0; i < 8; ++i) { o[0][i] = sc[j0 + i]; o[1][i] = sc[DFF + j0 + i]; } }
            else {
#pragma unroll
                for (int i = 0; i < 8; ++i) { o[0][i] = 0.f; o[1][i] = 0.f; } } };
        load_hist(r0, 2, xa); load_hist(r0, 1, xb);
        float xc[2][8]; load_row(r0, xc);
        for (int m = r0; m < r1; ++m) {
            float xn[2][8];
            if (m + 1 < r1) load_row(m + 1, xn);
            const int t = m < MP ? (m & (SEQ - 1)) : ((m - MP) & 7);
            if (t == 0 && m != r0) { load_hist(m, 2, xa); load_hist(m, 1, xb); }
            else if (t == 1 && m != r0) { load_hist(m, 2, xa); }
            float ca[8], cg[8];
#pragma unroll
            for (int i = 0; i < 8; ++i) { ca[i] = bb[0][i] + xa[0][i] * w0[0][i] + xb[0][i] * w1[0][i] + xc[0][i] * w2[0][i]; cg[i] = bb[1][i] + xa[1][i] * w0[1][i] + xb[1][i] * w1[1][i] + xc[1][i] * w2[1][i]; }
            v4u w;
            w.x = pk2(gelu_tanh(cg[0]) * ca[0], gelu_tanh(cg[1]) * ca[1]); w.y = pk2(gelu_tanh(cg[2]) * ca[2], gelu_tanh(cg[3]) * ca[3]);
            w.z = pk2(gelu_tanh(cg[4]) * ca[4], gelu_tanh(cg[5]) * ca[5]); w.w = pk2(gelu_tanh(cg[6]) * ca[6], gelu_tanh(cg[7]) * ca[7]);
            *(v4u*)(ACT + (size_t)m * DFF + j0) = w;
#pragma unroll
            for (int hf = 0; hf < 2; ++hf)
#pragma unroll
                for (int i = 0; i < 8; ++i) { xa[hf][i] = xb[hf][i]; xb[hf][i] = xc[hf][i]; xc[hf][i] = xn[hf][i]; }
        }
    }
}

template <class F> __device__ __forceinline__ void skinny_unit(Ctx& C, const bf16* A, const bf16* Bt, int K, int unit, const F& f) {
    const int rb = unit & 15, cb = unit >> 4;
    const int lane = C.lane, w = C.wave, r16 = lane & 15, fq = lane >> 4;
    const int kw = K >> 3, k0 = w * kw;
    f32x4 acc[4];
#pragma unroll
    for (int n = 0; n < 4; ++n) acc[n] = (f32x4){0.f, 0.f, 0.f, 0.f};
    const bf16* ap = A + (size_t)(rb * 16 + r16) * K + k0 + 8 * fq;
    const bf16* bp = Bt + (size_t)(cb * 64 + r16) * K + k0 + 8 * fq;
    for (int ks = 0; ks < kw; ks += 32) {
        const bf16x8 a = *(const bf16x8*)(ap + ks);
#pragma unroll
        for (int n = 0; n < 4; ++n) { const bf16x8 bv = *(const bf16x8*)(bp + (size_t)n * 16 * K + ks); acc[n] = __builtin_amdgcn_mfma_f32_16x16x32_bf16(a, bv, acc[n], 0, 0, 0); }
    }
    LAS float* red = (LAS float*)(C.lds + RING_OFF);
    __syncthreads();
#pragma unroll
    for (int n = 0; n < 4; ++n)
#pragma unroll
        for (int r = 0; r < 4; ++r) red[(w * 16 + 4 * fq + r) * 64 + 16 * n + r16] = acc[n][r];
    __syncthreads();
    { const int row = C.tid >> 5, c2 = (C.tid & 31) * 2; float s0 = 0.f, s1 = 0.f;
#pragma unroll
      for (int ww = 0; ww < 8; ++ww) { s0 += red[(ww * 16 + row) * 64 + c2]; s1 += red[(ww * 16 + row) * 64 + c2 + 1]; }
      f.store2(MP + rb * 16 + row, cb * 64 + c2, s0, s1); }
    __syncthreads();
}
struct SkProjA { const bf16* U; float* TA;
    __device__ __forceinline__ void store2(int row, int col, float a, float b) const { const unsigned g = *(const unsigned*)(U + (size_t)row * NU + UC_GA + col);
        *(f32x2v*)(TA + (size_t)row * DM + col) = (f32x2v){a * sigmoidf_(bflo(g)), b * sigmoidf_(bfhi(g))}; } };
struct SkProjB { const bf16* U; const float* TA; bf16* MG;
    __device__ __forceinline__ void store2(int row, int col, float a, float b) const { const unsigned g = *(const unsigned*)(U + (size_t)row * NU + UC_GB + col); const f32x2v t = *(const f32x2v*)(TA + (size_t)row * DM + col);
        *(unsigned*)(MG + (size_t)row * DM + col) = pk2(t[0] + a * sigmoidf_(bflo(g)), t[1] + b * sigmoidf_(bfhi(g))); } };
struct SkF32 { float* O;
    __device__ __forceinline__ void store2(int row, int col, float a, float b) const { *(f32x2v*)(O + (size_t)row * DM + col) = (f32x2v){a, b}; } };

constexpr int NPHASE = 14;
__global__ void __launch_bounds__(NTHR, 2) mk_fwd(Args args) {
    extern __shared__ __attribute__((aligned(16))) unsigned char lds[];
    Ctx C;
    C.lds = (LAS unsigned char*)lds;
    C.tid = threadIdx.x; C.lane = C.tid & 63; C.wave = __builtin_amdgcn_readfirstlane(C.tid >> 6);
    C.G = gridDim.x; C.bid = blockIdx.x;
    C.ka = (const char KAS*)__builtin_amdgcn_kernarg_segment_ptr();
    C.out = *(float* const KAS*)(C.ka + 192); C.ws = *(unsigned char* const KAS*)(C.ka + 200);
    unsigned char* ws = C.ws;
    for (int u = C.tid; u < (LDS_BYTES - LDSCTL_OFF) / 4; u += NTHR) ((LAS unsigned*)(C.lds + LDSCTL_OFF))[u] = 0u;
    __syncthreads();
    const int lo = *(const int KAS*)(C.ka + 208), hi = *(const int KAS*)(C.ka + 212);
    const bool multi = (hi - lo) > 1;
    XcdBarrier bar; bar.bar = (unsigned*)(ws + WS_CTL) + CW_BAR; bar.x = 0; bar.st = nullptr;
    if (multi) bar = xcd_barrier_post((unsigned*)(ws + WS_CTL) + CW_BAR, (volatile LAS unsigned*)(C.lds + MISC_OFF) + 8);
#ifndef PHASE_MASK
#define PHASE_MASK 0xFFFF
#endif
#define IN(k) (((PHASE_MASK >> (k)) & 1) && lo <= (k) && (k) < hi)
#define SEAM(k) do { if (IN(k) && IN((k) + 1)) xcd_barrier(bar); } while (0)
#define REFRESH() do { int t_ = threadIdx.x; asm volatile("" : "+v"(t_)); C.tid = t_; C.lane = t_ & 63; } while (0)
    bf16* U = (bf16*)(ws + WS_U);

    if (IN(0)) { REFRESH(); p0_prologue(C); } SEAM(0);

    if (IN(1)) { REFRESH();
        pg8::Gemm g{(const bf16*)(ws + WS_XN), (const bf16*)(ws + WS_WIN), MT, NU, DM}; pg8::StaticOrder S; S.init(MT, NU, C.G, C.bid);
        pg8::EpiGen<StInProj> E{{U, C.out, (float*)(ws + WS_ALOW), (float*)(ws + WS_FA)}};
        pg8::gemm_phase<pg8::EpiGen<StInProj>, pg8::StaticOrder, true, true>(C.lds + RING_OFF, g, S, E);
    } SEAM(1);

    if (IN(2)) { REFRESH(); p2_scans(C); for (int u = C.bid; u < 256; u += C.G) gla::b1_unit(C, u); } SEAM(2);

    if (IN(3)) { REFRESH();
        gla::b2_scan(C);
        {
            unsigned* qh = (unsigned*)(ws + WS_CTL) + CW_Q; volatile LAS int* qslot = (volatile LAS int*)(C.lds + MISC_OFF + 64);
            const int home = (int)(xb_xcc_id() & 7u);
            for (int qi = 0; qi < 8; ++qi) { const int x = (home + qi) & 7;
                for (;;) {
                    __syncthreads();
                    if (C.tid == 0) *qslot = (int)__hip_atomic_fetch_add(qh + 64 * x, 1u, __ATOMIC_RELAXED, __HIP_MEMORY_SCOPE_AGENT);
                    __syncthreads();
                    const int e = __builtin_amdgcn_readfirstlane(*qslot);
                    if (e >= 112) break;
                    { int t_ = threadIdx.x; asm volatile("" : "+v"(t_)); C.tid = t_; C.lane = t_ & 63; C.wave = __builtin_amdgcn_readfirstlane(t_ >> 6); }
                    if (e < 96) { const int g = e / 3, r = e - 3 * g;
                        if (r < 2) { const int k = 2 * g + r; att::attn_unit<8>(C.tid, (x + 8 * (k & 1)) >> 3, (x + 8 * (k & 1)) & 7, 31 - (k >> 1), U, (const float*)(ws + WS_CB), (bf16*)(ws + WS_OA), C.lds + RING_OFF); }
                        else { const int w = g * 8 + x; sattn_unit(C, w >> 3, w & 7); } }
                    else gla::sample_unit(C, (e - 96) * 8 + x);
                }
            }
        }
    } SEAM(3);

    if (IN(4)) { REFRESH(); for (int u = C.bid; u < 256; u += C.G) gla::b3_unit(C, u); sattn_combine(C); } SEAM(4);

    if (IN(5)) { REFRESH(); gla_post(C); } SEAM(5);

    if (IN(6)) { REFRESH();
        { pg8::Gemm g{(const bf16*)(ws + WS_OA), (const bf16*)(ws + WS_WPA), MP, DM, AW}; pg8::StaticOrder S; S.init(MP, DM, C.G, C.bid);
          pg8::EpiGen<StProjA> E{{U, (float*)(ws + WS_TA)}};
          pg8::gemm_phase<pg8::EpiGen<StProjA>, pg8::StaticOrder, true, true>(C.lds + RING_OFF, g, S, E); }
        for (int u = C.bid; u < 256; u += C.G) skinny_unit(C, (const bf16*)(ws + WS_OA) + (size_t)MP * AW, (const bf16*)(ws + WS_WPA), AW, u, SkProjA{U, (float*)(ws + WS_TA)});
        asm volatile("s_waitcnt vmcnt(0)" ::: "memory"); __syncthreads();
        { pg8::Gemm g{(const bf16*)(ws + WS_OB), (const bf16*)(ws + WS_WPB), MP, DM, BVW}; pg8::StaticOrder S; S.init(MP, DM, C.G, C.bid);
          pg8::EpiGen<StProjB> E{{U, (const float*)(ws + WS_TA), (bf16*)(ws + WS_MG)}};
          pg8::gemm_phase<pg8::EpiGen<StProjB>, pg8::StaticOrder, true, true>(C.lds + RING_OFF, g, S, E); }
        for (int u = C.bid; u < 256; u += C.G) skinny_unit(C, (const bf16*)(ws + WS_OB) + (size_t)MP * BVW, (const bf16*)(ws + WS_WPB), BVW, u, SkProjB{U, (const float*)(ws + WS_TA), (bf16*)(ws + WS_MG)});
    } SEAM(6);


    if (IN(8)) { REFRESH();
        { pg8::Gemm g{(const bf16*)(ws + WS_MG), (const bf16*)(ws + WS_WOUT), MP, DM, DM}; pg8::StaticOrder S; S.init(MP, DM, C.G, C.bid);
          pg8::EpiGen<StF32> E{{(float*)(ws + WS_F1)}};
          pg8::gemm_phase<pg8::EpiGen<StF32>, pg8::StaticOrder, true, true>(C.lds + RING_OFF, g, S, E); }
        for (int u = C.bid; u < 256; u += C.G) skinny_unit(C, (const bf16*)(ws + WS_MG) + (size_t)MP * DM, (const bf16*)(ws + WS_WOUT), DM, u, SkF32{(float*)(ws + WS_F1)});
    } SEAM(8);

    if (IN(9)) { REFRESH(); p7_rows(C); } SEAM(9);

    if (IN(10)) { REFRESH();
        pg8::Gemm g{(const bf16*)(ws + WS_XN2), (const bf16*)(ws + WS_WUP), MT, DFF2, DM}; pg8::StaticOrder S; S.init(MT, DFF2, C.G, C.bid);
        pg8::EpiGen<StUp> E{{(bf16*)(ws + WS_UU), C.out}};
        pg8::gemm_phase<pg8::EpiGen<StUp>, pg8::StaticOrder, true, true>(C.lds + RING_OFF, g, S, E);
    } SEAM(10);

    if (IN(11)) { REFRESH(); p9_conv(C); } SEAM(11);

    if (IN(12)) { REFRESH();
        { pg8::Gemm g{(const bf16*)(ws + WS_ACT), (const bf16*)(ws + WS_WDN), MP, DM, DFF}; pg8::StaticOrder S; S.init(MP, DM, C.G, C.bid);
          pg8::EpiGen<StF32> E{{(float*)(ws + WS_F2)}};
          pg8::gemm_phase<pg8::EpiGen<StF32>, pg8::StaticOrder, true, true>(C.lds + RING_OFF, g, S, E); }
        for (int u = C.bid; u < 256; u += C.G) skinny_unit(C, (const bf16*)(ws + WS_ACT) + (size_t)MP * DFF, (const bf16*)(ws + WS_WDN), DFF, u, SkF32{(float*)(ws + WS_F2)});
    } SEAM(12);


    if (IN(13)) { REFRESH(); p11_rows(C); }
#undef IN
#undef SEAM
}

#ifndef MK_SPLIT
#define MK_SPLIT 0
#endif
extern "C" void kernel_launch(void* const* d_in, const int* in_sizes, int n_in, void* d_out, int out_size, void* d_ws, size_t ws_size, hipStream_t stream) {
    static int grid = 0;
    if (grid == 0) {
        if (n_in != 24 || (size_t)out_size != OUT_TOTAL || ws_size < WS_END) { fprintf(stderr, "kernel_launch: unexpected problem (n_in %d, out %d, ws %zu)\n", n_in, out_size, ws_size); grid = -1; return; }
        int dev = 0, cus = 0, per_cu = 0;
        if (hipGetDevice(&dev) != hipSuccess || hipDeviceGetAttribute(&cus, hipDeviceAttributeMultiprocessorCount, dev) != hipSuccess) { grid = -1; return; }
        if (hipFuncSetAttribute((const void*)mk_fwd, hipFuncAttributeMaxDynamicSharedMemorySize, LDS_BYTES) != hipSuccess) { fprintf(stderr, "kernel_launch: hipFuncSetAttribute failed\n"); grid = -1; return; }
        if (hipOccupancyMaxActiveBlocksPerMultiprocessor(&per_cu, (const void*)mk_fwd, NTHR, LDS_BYTES) != hipSuccess || per_cu < 1) fprintf(stderr, "kernel_launch: occupancy query reports %d\n", per_cu);
        (void)hipGetLastError();
        grid = cus;
    }
    if (grid < 0) return;
    if (hipMemsetAsync((char*)d_ws + WS_CTL, 0, CTL_ZERO_BYTES, stream) != hipSuccess) return;
    Args a{};
    for (int i = 0; i < 24; ++i) a.in[i] = d_in[i];
    a.out = (float*)d_out; a.ws = (unsigned char*)d_ws;
#if MK_SPLIT
    for (int p = 0; p < NPHASE; ++p) { a.ph_lo = p; a.ph_hi = p + 1; hipLaunchKernelGGL(mk_fwd, dim3(grid), dim3(NTHR), LDS_BYTES, stream, a); }
#else
    a.ph_lo = 0; a.ph_hi = NPHASE;
    hipLaunchKernelGGL(mk_fwd, dim3(grid), dim3(NTHR), LDS_BYTES, stream, a);
#endif
    const hipError_t le = hipPeekAtLastError();
    if (le != hipSuccess) fprintf(stderr, "kernel_launch: launch failed: %s\n", hipGetErrorName(le));
}
```
